# Optimizing an MI355X kernel written in HIP

```python
import jax, jax.numpy as jnp
from jax import lax
import numpy as np

D_MODEL = 1024
BATCH = 8
SEQ = 8192
DEPTH = 1

GRID_W = 64
CTX_LEN = 256
EPS = 1e-6

RET_HEADS = 4
RET_QK_DIM = 256
RET_V_DIM = 512
RET_CHUNK = 128
ATTN_HEADS = 8
ATTN_KV_HEADS = 2
ATTN_HEAD_DIM = 128
Q_BLOCK = 128
ROPE_THETA = 10000.0
N_EXPERTS = 32
TOP_K = 4
EXPERT_FF = 1024
SWIGLU_LIMIT = 7.0
SWIGLU_ALPHA = 1.702

RET_QK_W = RET_HEADS * RET_QK_DIM
RET_V_W = RET_HEADS * RET_V_DIM
ATTN_Q_W = ATTN_HEADS * ATTN_HEAD_DIM
ATTN_KV_W = ATTN_KV_HEADS * ATTN_HEAD_DIM
IN_SIZES = (RET_QK_W, RET_QK_W, RET_V_W, RET_V_W, ATTN_Q_W, ATTN_KV_W, ATTN_KV_W, D_MODEL, D_MODEL)
IN_WIDTH = sum(IN_SIZES)

kernel_name = 'hybrid_retention_gqa_moe_diffusion_block'


def rms_norm(x, gain=None):
    xf = x.astype(jnp.float32)
    y = xf * lax.rsqrt(jnp.mean(xf * xf, axis=-1, keepdims=True) + EPS)
    if gain is not None:
        y = y * gain.astype(jnp.float32)
    return y.astype(x.dtype)


def modulate(x, gain, shift, scale):
    return rms_norm(x, gain) * (1 + scale) + shift


def split_in_proj(p):
    idx = np.cumsum(IN_SIZES)[:-1].tolist()
    return jnp.split(p, idx, axis=-1)


def split_heads(t, n_heads):
    b, l, w = t.shape
    return t.reshape(b, l, n_heads, w // n_heads).transpose(0, 2, 1, 3)


def merge_heads(t):
    b, n, l, d = t.shape
    return t.transpose(0, 2, 1, 3).reshape(b, l, n * d)


def axial_rope(rows, head_dim):
    row_id = jnp.broadcast_to(jnp.arange(rows, dtype=jnp.float32)[:, None], (rows, GRID_W)).reshape(-1)
    col_id = jnp.broadcast_to(jnp.arange(GRID_W, dtype=jnp.float32)[None, :], (rows, GRID_W)).reshape(-1)
    n_freq = head_dim // 4
    inv_freq = ROPE_THETA ** (-jnp.arange(n_freq, dtype=jnp.float32) / n_freq)
    ang = jnp.stack([row_id[:, None] * inv_freq, col_id[:, None] * inv_freq], axis=1)
    return jnp.cos(ang), jnp.sin(ang)


def apply_rope(x, cos, sin):
    shp = x.shape
    xf = x.astype(jnp.float32).reshape(shp[:-1] + (2, 2, shp[-1] // 4))
    x1, x2 = xf[..., 0, :], xf[..., 1, :]
    o = jnp.stack([x1 * cos - x2 * sin, x2 * cos + x1 * sin], axis=-2)
    return o.reshape(shp).astype(x.dtype)


def retention_scan(q, k, v, log_gamma, s0, include_diag):
    b, h, l, dk = q.shape
    dv = v.shape[-1]
    n_chunks = l // RET_CHUNK
    pos = jnp.arange(RET_CHUNK, dtype=jnp.float32)
    diff = pos[:, None] - pos[None, :]
    mask = (diff >= 0) if include_diag else (diff > 0)
    lg = log_gamma.astype(jnp.float32)
    d_intra = jnp.where(mask[None], jnp.exp(lg[:, None, None] * jnp.maximum(diff, 0.0)[None]), 0.0)
    d_in = jnp.exp(lg[:, None] * (pos + 1.0))[None, :, :, None]
    d_out = jnp.exp(lg[:, None] * (RET_CHUNK - 1.0 - pos))[None, :, :, None]
    d_chunk = jnp.exp(lg * RET_CHUNK)[None, :, None, None]

    def to_chunks(t):
        return t.reshape(b, h, n_chunks, RET_CHUNK, t.shape[-1]).transpose(2, 0, 1, 3, 4)

    def step(s, xs):
        qc, kc, vc = (t.astype(jnp.float32) for t in xs)
        scores = jnp.einsum('bhid,bhjd->bhij', qc, kc) * d_intra
        o = jnp.einsum('bhij,bhje->bhie', scores, vc) + jnp.einsum('bhid,bhde->bhie', qc, s) * d_in
        s = s * d_chunk + jnp.einsum('bhjd,bhje->bhde', kc * d_out, vc)
        return s, o

    s_fin, o = lax.scan(step, s0, (to_chunks(q), to_chunks(k), to_chunks(v)))
    o = o.transpose(1, 2, 0, 3, 4).reshape(b, h, l, dv).astype(v.dtype)
    return o, s_fin


def bidir_retention(q, k, v, lg_f, lg_b, s_f0, s_b0):
    o_f, s_f = retention_scan(q, k, v, lg_f, s_f0, True)
    o_b, s_b = retention_scan(jnp.flip(q, 2), jnp.flip(k, 2), jnp.flip(v, 2), lg_b, s_b0, False)
    return o_f + jnp.flip(o_b, 2), s_f, s_b


def block_attention(q, k, v):
    b, kvh, g, lq, d = q.shape
    n_blk = lq // Q_BLOCK
    qb = jnp.moveaxis(q.reshape(b, kvh, g, n_blk, Q_BLOCK, d), 3, 0)
    scale = d ** -0.5

    def one_block(q_blk):
        s = jnp.einsum('bkgqd,bksd->bkgqs', q_blk, k, preferred_element_type=jnp.float32) * scale
        p = jax.nn.softmax(s, axis=-1)
        return jnp.einsum('bkgqs,bksd->bkgqd', p.astype(v.dtype), v,
                          preferred_element_type=jnp.float32).astype(v.dtype)

    o = lax.map(one_block, qb)
    return jnp.moveaxis(o, 0, 3).reshape(b, kvh * g, lq, d)


def group_q(t):
    b, h, l, d = t.shape
    return t.reshape(b, ATTN_KV_HEADS, h // ATTN_KV_HEADS, l, d)


def merge_branches(ret_o, ret_g, attn_o, gate_r, gate_a, w_ret_o, w_attn_o, w_out):
    ret_branch = (jax.nn.silu(ret_g) * merge_heads(rms_norm(ret_o))) @ w_ret_o
    attn_branch = merge_heads(attn_o) @ w_attn_o
    y = jax.nn.sigmoid(gate_r) * ret_branch + jax.nn.sigmoid(gate_a) * attn_branch
    return y @ w_out


def moe(h, w_router, b_router, w1, b1, w2, b2):
    shp = h.shape
    t = h.reshape(-1, shp[-1])
    logits = (t @ w_router).astype(jnp.float32) + b_router.astype(jnp.float32)
    top_v, top_i = lax.top_k(logits, TOP_K)
    wts = jax.nn.softmax(top_v, axis=-1)
    comb = jnp.sum(jax.nn.one_hot(top_i, N_EXPERTS, dtype=jnp.float32) * wts[..., None], axis=1)

    def expert(acc, xs):
        w1e, b1e, w2e, b2e, ce = xs
        a = t @ w1e + b1e
        gate = jnp.minimum(a[:, :EXPERT_FF], SWIGLU_LIMIT)
        up = jnp.clip(a[:, EXPERT_FF:], -SWIGLU_LIMIT, SWIGLU_LIMIT)
        out = (gate * jax.nn.sigmoid(SWIGLU_ALPHA * gate) * (up + 1)) @ w2e + b2e
        return acc + ce[:, None].astype(out.dtype) * out, None

    out, _ = lax.scan(expert, jnp.zeros_like(t), (w1, b1, w2, b2, comb.T))
    return out.reshape(shp)


def setup_inputs(seed: int = 0) -> dict:
    key = jax.random.key(seed)
    ks = jax.random.split(key, 24)
    f32 = jnp.float32

    def nrm(k, shape, scale):
        return jax.random.normal(k, shape, f32) * scale

    base = -np.log1p(-2.0 ** (-5.0 - np.arange(RET_HEADS)))
    raw = jnp.asarray(np.log(np.expm1(base)).astype(np.float32))
    return {
        'x': nrm(ks[0], (BATCH, SEQ, D_MODEL), 1.0),
        'c': nrm(ks[1], (BATCH, D_MODEL), 1.0),
        'ctx': nrm(ks[2], (BATCH, CTX_LEN, D_MODEL), 1.0),
        'c_ctx': nrm(ks[3], (D_MODEL,), 1.0),
        'norm1': 1.0 + nrm(ks[4], (DEPTH, D_MODEL), 0.01),
        'norm2': 1.0 + nrm(ks[5], (DEPTH, D_MODEL), 0.01),
        'w_ada': nrm(ks[6], (DEPTH, D_MODEL, 6 * D_MODEL), 0.5 * D_MODEL ** -0.5),
        'b_ada': nrm(ks[7], (DEPTH, 6 * D_MODEL), 0.01),
        'w_in': nrm(ks[8], (DEPTH, D_MODEL, IN_WIDTH), D_MODEL ** -0.5),
        'ret_decay_f': raw + nrm(ks[9], (DEPTH, RET_HEADS), 0.05),
        'ret_decay_b': raw + nrm(ks[10], (DEPTH, RET_HEADS), 0.05),
        'attn_q_norm': 1.0 + nrm(ks[11], (DEPTH, ATTN_HEAD_DIM), 0.01),
        'attn_k_norm': 1.0 + nrm(ks[12], (DEPTH, ATTN_HEAD_DIM), 0.01),
        'w_ret_o': nrm(ks[13], (DEPTH, RET_V_W, D_MODEL), RET_V_W ** -0.5),
        'w_attn_o': nrm(ks[14], (DEPTH, ATTN_Q_W, D_MODEL), ATTN_Q_W ** -0.5),
        'w_out': nrm(ks[15], (DEPTH, D_MODEL, D_MODEL), D_MODEL ** -0.5),
        'w_router': nrm(ks[16], (DEPTH, D_MODEL, N_EXPERTS), D_MODEL ** -0.5),
        'b_router': nrm(ks[17], (DEPTH, N_EXPERTS), 0.01),
        'w_exp_in': nrm(ks[18], (DEPTH, N_EXPERTS, D_MODEL, 2 * EXPERT_FF), D_MODEL ** -0.5),
        'b_exp_in': nrm(ks[19], (DEPTH, N_EXPERTS, 2 * EXPERT_FF), 0.01),
        'w_exp_out': nrm(ks[20], (DEPTH, N_EXPERTS, EXPERT_FF, D_MODEL), EXPERT_FF ** -0.5),
        'b_exp_out': nrm(ks[21], (DEPTH, N_EXPERTS, D_MODEL), 0.01),
    }


def reference(x, c, ctx, c_ctx, norm1, norm2, w_ada, b_ada, w_in, ret_decay_f, ret_decay_b,
              attn_q_norm, attn_k_norm, w_ret_o, w_attn_o, w_out, w_router, b_router,
              w_exp_in, b_exp_in, w_exp_out, b_exp_out):
    b = x.shape[0]
    rows = x.shape[1] // GRID_W
    rope_ret = axial_rope(rows, RET_QK_DIM)
    rope_attn = axial_rope(rows, ATTN_HEAD_DIM)
    k_scale = RET_QK_DIM ** -0.5
    zero_state = jnp.zeros((b, RET_HEADS, RET_QK_DIM, RET_V_DIM), jnp.float32)

    for i in range(DEPTH):
        mod = jax.nn.silu(c) @ w_ada[i] + b_ada[i]
        mod_c = jax.nn.silu(c_ctx) @ w_ada[i] + b_ada[i]
        sh1, sc1, g1, sh2, sc2, g2 = jnp.split(mod[:, None, :], 6, axis=-1)
        sh1c, sc1c, g1c, sh2c, sc2c, g2c = jnp.split(mod_c, 6, axis=-1)

        h = modulate(x, norm1[i], sh1, sc1)
        hc = modulate(ctx, norm1[i], sh1c, sc1c)
        qr, kr, vr, gr, qa, ka, va, gate_r, gate_a = split_in_proj(h @ w_in[i])
        qrc, krc, vrc, grc, qac, kac, vac, gate_rc, gate_ac = split_in_proj(hc @ w_in[i])

        lg_f = -jax.nn.softplus(ret_decay_f[i].astype(jnp.float32))
        lg_b = -jax.nn.softplus(ret_decay_b[i].astype(jnp.float32))
        o_rc, s_f, s_b = bidir_retention(split_heads(qrc, RET_HEADS), split_heads(krc, RET_HEADS) * k_scale,
                                         split_heads(vrc, RET_HEADS), lg_f, lg_b, zero_state, zero_state)
        q_r = apply_rope(split_heads(qr, RET_HEADS), *rope_ret)
        k_r = apply_rope(split_heads(kr, RET_HEADS), *rope_ret) * k_scale
        o_r, _, _ = bidir_retention(q_r, k_r, split_heads(vr, RET_HEADS), lg_f, lg_b, s_f, s_b)

        k_ac = rms_norm(split_heads(kac, ATTN_KV_HEADS), attn_k_norm[i])
        v_ac = split_heads(vac, ATTN_KV_HEADS)
        q_a = apply_rope(rms_norm(split_heads(qa, ATTN_HEADS), attn_q_norm[i]), *rope_attn)
        k_a = apply_rope(rms_norm(split_heads(ka, ATTN_KV_HEADS), attn_k_norm[i]), *rope_attn)
        v_a = split_heads(va, ATTN_KV_HEADS)
        o_a = block_attention(group_q(q_a), jnp.concatenate([k_ac, k_a], axis=2),
                              jnp.concatenate([v_ac, v_a], axis=2))

        x = x + g1 * merge_branches(o_r, gr, o_a, gate_r, gate_a, w_ret_o[i], w_attn_o[i], w_out[i])

        if i + 1 < DEPTH:
            q_ac = rms_norm(split_heads(qac, ATTN_HEADS), attn_q_norm[i])
            o_ac = block_attention(group_q(q_ac), k_ac, v_ac)
            ctx = ctx + g1c * merge_branches(o_rc, grc, o_ac, gate_rc, gate_ac, w_ret_o[i], w_attn_o[i], w_out[i])
            ctx = ctx + g2c * moe(modulate(ctx, norm2[i], sh2c, sc2c), w_router[i], b_router[i],
                                  w_exp_in[i], b_exp_in[i], w_exp_out[i], b_exp_out[i])

        x = x + g2 * moe(modulate(x, norm2[i], sh2, sc2), w_router[i], b_router[i],
                         w_exp_in[i], b_exp_in[i], w_exp_out[i], b_exp_out[i])
    return x
```

```cpp
#include <hip/hip_runtime.h>
#include <cstdio>
#include <cstdint>
#include <cstring>

#define GAS __attribute__((address_space(1)))
#define LAS __attribute__((address_space(3)))
#define DI __device__ __forceinline__
typedef unsigned short bf16;
typedef unsigned v4u __attribute__((ext_vector_type(4)));
typedef unsigned v2u __attribute__((ext_vector_type(2)));
typedef float f32x4 __attribute__((ext_vector_type(4)));
typedef float f32x2 __attribute__((ext_vector_type(2)));
typedef float f32x16 __attribute__((ext_vector_type(16)));
typedef short bf16x8 __attribute__((ext_vector_type(8)));
typedef short s16x4 __attribute__((ext_vector_type(4)));
typedef GAS unsigned gu32;
#define RLX_AGENT __ATOMIC_RELAXED, __HIP_MEMORY_SCOPE_AGENT
#define LDS_WAIT() asm volatile("s_waitcnt lgkmcnt(0)" ::: "memory")
#define VM_WAIT() asm volatile("s_waitcnt vmcnt(0)" ::: "memory")

constexpr int NB = 8, SEQ = 8192, DM = 1024, LCTX = 256;
constexpr int LT = SEQ + LCTX;
constexpr int TTOK = NB * SEQ;
constexpr int MROWS = NB * LT;
constexpr int NBH = 4;
constexpr int MH = NBH * LT;
constexpr int TPB = LT / 256;
constexpr int INW = 9728;
constexpr int NEXP = 32, EFF = 1024;
constexpr float EPS = 1e-6f;
constexpr int NWAVES = 8;

constexpr size_t MiB = 1u << 20;
constexpr size_t WS_CTL = 0, CTL_ZERO_BYTES = 1 * MiB;
constexpr size_t WS_SMALL = 1 * MiB;
constexpr size_t WS_MOD   = WS_SMALL;
constexpr size_t WS_COSR  = WS_SMALL + 256 * 1024;
constexpr size_t WS_SINR  = WS_COSR + 32 * 1024;
constexpr size_t WS_COSA  = WS_SINR + 32 * 1024;
constexpr size_t WS_SINA  = WS_COSA + 16 * 1024;
constexpr size_t WS_TOPE  = WS_SMALL + 1 * MiB;
constexpr size_t WS_TOPW  = WS_SMALL + 2 * MiB;
constexpr size_t WS_WCNT  = WS_SMALL + 3 * MiB;
constexpr size_t WS_ROWTOK = WS_SMALL + 4 * MiB;
constexpr size_t WS_ROWDST = WS_SMALL + 5 * MiB;
constexpr size_t WS_ROWW  = WS_SMALL + 6 * MiB;
constexpr size_t WS_TILEB = WS_SMALL + 7 * MiB;
constexpr size_t WS_PART  = WS_SMALL + 8 * MiB;
constexpr size_t WS_WIN  = 17 * MiB;
constexpr size_t WS_WRO  = 36 * MiB;
constexpr size_t WS_WAO  = 40 * MiB;
constexpr size_t WS_WOUT = 42 * MiB;
constexpr size_t WS_W1   = 44 * MiB;
constexpr size_t WS_W2   = 172 * MiB;
constexpr size_t WS_H1   = 236 * MiB;
constexpr size_t WS_Y    = 302 * MiB;
constexpr size_t WS_QR = 368 * MiB, WS_KR = 434 * MiB, WS_VR = 500 * MiB;
constexpr size_t WS_OF = 632 * MiB, WS_OB = 764 * MiB;
constexpr size_t WS_GR = 368 * MiB, WS_QA = 500 * MiB, WS_GTR = 566 * MiB, WS_GTA = 896 * MiB, WS_KA = 962 * MiB, WS_VA = 979 * MiB;
constexpr size_t WS_KA8 = 996 * MiB;
constexpr size_t WS_VA8 = 1005 * MiB;
constexpr size_t WS_O8 = WS_KA;
constexpr size_t WS_END = 1014 * MiB;
constexpr size_t WS_H2 = 236 * MiB;
constexpr size_t WS_ACT = 368 * MiB;
constexpr size_t WS_Y2 = 640 * MiB;
constexpr int TH_TOK = TTOK / 2;
constexpr int ACT_CAP = TH_TOK * 4 + 32 * 256;
static_assert(WS_VA + (size_t)MH * 256 * 2 <= WS_END && WS_KA + (size_t)MH * 256 * 2 <= WS_VA, "ws map");
static_assert(WS_Y2 + (size_t)ACT_CAP * 1024 * 2 <= WS_KA8 && WS_ACT + (size_t)ACT_CAP * 2048 <= WS_Y2, "ws map moe");
constexpr int CW_TMO = 0, CW_CODE = 1;
constexpr int CW_BAR = 4096;

constexpr int RING_OFF = 0, RING_BYTES = 159744;
constexpr int LDSCTL_OFF = RING_BYTES, MISC_OFF = LDSCTL_OFF + 320;
constexpr int LDS_BYTES = 163840;

DI unsigned cvt_pk_bf16(float lo, float hi) { unsigned r; asm volatile("v_cvt_pk_bf16_f32 %0, %1, %2" : "=v"(r) : "v"(lo), "v"(hi)); return r; }
DI unsigned pk4_fp8(float a, float b, float c, float d) { int p = 0; p = __builtin_amdgcn_cvt_pk_fp8_f32(a, b, p, false); p = __builtin_amdgcn_cvt_pk_fp8_f32(c, d, p, true); return (unsigned)p; }
DI float bf_lo(unsigned u) { return __uint_as_float(u << 16); }
DI float bf_hi(unsigned u) { return __uint_as_float(u & 0xffff0000u); }
template <int O> DI float lane_xor(float v) { static_assert(O > 0 && O < 32, "lane_xor"); return __int_as_float(__builtin_amdgcn_ds_swizzle(__float_as_int(v), 0x1f | (O << 10))); }
DI float wave_sum(float v) {
    v += lane_xor<1>(v); v += lane_xor<2>(v); v += lane_xor<4>(v); v += lane_xor<8>(v); v += lane_xor<16>(v);
    auto rr = __builtin_amdgcn_permlane32_swap(__float_as_uint(v), __float_as_uint(v), false, false);
    return __uint_as_float(rr[0]) + __uint_as_float(rr[1]);
}
DI float fast_sigmoid(float x) { return __builtin_amdgcn_rcpf(1.0f + __expf(-x)); }

DI int hw_wave_key() { return (int)__builtin_amdgcn_s_getreg((5 << 11) | 4) & 63; }
DI int opaque_tid() {
    int w = *(volatile LAS int*)(uintptr_t)(LDSCTL_OFF + 4 * hw_wave_key());
    w = __builtin_amdgcn_readfirstlane(w);
    unsigned z; asm volatile("v_mov_b32 %0, 0" : "=v"(z));
    int t = w * 64 + (int)__builtin_amdgcn_mbcnt_hi(~0u, __builtin_amdgcn_mbcnt_lo(~0u, z));
    asm volatile("" : "+v"(t)); return t;
}

DI int fresh_lane() { unsigned z; asm volatile("v_mov_b32 %0, 0" : "=v"(z)); int l = (int)__builtin_amdgcn_mbcnt_hi(~0u, __builtin_amdgcn_mbcnt_lo(~0u, z)); asm volatile("" : "+v"(l)); return l; }

#define XB_TMO      128
#define XB_XCNT(j)  (256  + 64 * (j))
#define XB_XSUB(j)  (1280 + 64 * (j))
#define XB_XGEN(j)  (2304 + 64 * (j))
#define XB_TOP      3328
#define XB_TOPGEN   3392
#define XCD_BAR_WORDS 3456
#define XB_SPIN_CAP (1u << 18)

__device__ __forceinline__ unsigned xb_ld(unsigned* p)              { return __hip_atomic_load(p, __ATOMIC_RELAXED, __HIP_MEMORY_SCOPE_AGENT); }
__device__ __forceinline__ unsigned xb_add(unsigned* p, unsigned v) { return __hip_atomic_fetch_add(p, v, __ATOMIC_RELAXED, __HIP_MEMORY_SCOPE_AGENT); }
__device__ __forceinline__ unsigned xb_xcc_id() { return (unsigned)__builtin_amdgcn_s_getreg((3 << 11) | 20) & 0xFu; }
#define XB_SPIN(cond, bar) do { unsigned _sp = 0; while (cond) { __builtin_amdgcn_s_sleep(1); \
    if ((++_sp & 255u) == 0u) { if (xb_ld(&(bar)[XB_TMO])) break; if (_sp > XB_SPIN_CAP) { atomicAdd(&(bar)[XB_TMO], 1u); break; } } } } while (0)

struct XcdBarrier {
    unsigned* bar; unsigned x;
    volatile LAS unsigned* st;
};

__device__ __forceinline__ XcdBarrier xcd_barrier_post(unsigned* bar, volatile LAS unsigned* st) {
    XcdBarrier b; b.bar = bar; b.x = xb_xcc_id(); b.st = st;
    if (opaque_tid() == 0) (void)xb_add(&bar[XB_XCNT(b.x)], 1u);
    return b;
}
__device__ __forceinline__ void xcd_barrier_complete(unsigned* bar, unsigned x, unsigned& nloc, unsigned& nx) {
    const unsigned G = gridDim.x * gridDim.y * gridDim.z;
    unsigned sum, cnt, mine, sp = 0u;
    for (;;) {
        sum = 0u; cnt = 0u; mine = 0u;
#pragma unroll
        for (unsigned j = 0; j < 16; ++j) { const unsigned c = xb_ld(&bar[XB_XCNT(j)]); sum += c; cnt += (c > 0u) ? 1u : 0u; mine = (j == x) ? c : mine; }
        if (sum == G) break;
        __builtin_amdgcn_s_sleep(1);
        if ((++sp & 255u) == 0u) { if (xb_ld(&bar[XB_TMO])) break; if (sp > XB_SPIN_CAP) { atomicAdd(&bar[XB_TMO], 1u); break; } }
    }
    nloc = mine > 0u ? mine : 1u; nx = cnt > 0u ? cnt : 1u;
}

__device__ __forceinline__ void xcd_barrier(const XcdBarrier& b) {
    asm volatile("s_waitcnt vmcnt(0)" ::: "memory");
    __syncthreads();
    if (opaque_tid() == 0) {
        unsigned* bar = b.bar;
        __builtin_amdgcn_s_waitcnt(0);
        unsigned nloc = b.st[0], nx = b.st[1];
        if (nloc == 0u) { xcd_barrier_complete(bar, b.x, nloc, nx); b.st[0] = nloc; b.st[1] = nx; }
        const unsigned old = xb_add(&bar[XB_XSUB(b.x)], 1u);
        const unsigned gen = old / nloc;
        if (old + 1u == (gen + 1u) * nloc) {
            __builtin_amdgcn_fence(__ATOMIC_RELEASE, "agent");
            asm volatile("s_waitcnt vmcnt(0)" ::: "memory");
            const unsigned og = xb_add(&bar[XB_TOP], 1u);
            const unsigned tg = og / nx;
            if (og + 1u == (tg + 1u) * nx) xb_add(&bar[XB_TOPGEN], 1u);
            else XB_SPIN(xb_ld(&bar[XB_TOPGEN]) == tg, bar);
            __builtin_amdgcn_fence(__ATOMIC_ACQUIRE, "agent");
            xb_add(&bar[XB_XGEN(b.x)], 1u);
            asm volatile("s_waitcnt vmcnt(0)" ::: "memory");
        } else {
            XB_SPIN(xb_ld(&bar[XB_XGEN(b.x)]) == gen, bar);
            __builtin_amdgcn_fence(__ATOMIC_ACQUIRE, "agent");
            asm volatile("s_waitcnt vmcnt(0)" ::: "memory");
        }
    }
    __syncthreads();
}
namespace pg8 {
#define PG8_LAS __attribute__((address_space(3)))
constexpr int BM = 256, BK = 64, HALF = 128, HTB = HALF * BK * 2, STAGE_BYTES = 8 * HTB, NXCD = 8, WGM = 8;
__host__ __device__ __forceinline__ int lds_byte(int r, int c) { const int st = (r >> 4) * 2 + (c >> 5), rr = r & 15, cc = c & 31, ob = rr * 64 + cc * 2; return st * 1024 + (ob ^ (((ob >> 9) & 1) << 5)); }
__host__ __device__ __forceinline__ void stage_rc(int b, int& R, int& C) { const int st = b / 1024, sb = b % 1024, swz = sb ^ (((sb >> 9) & 1) << 5); R = (st >> 1) * 16 + swz / 64; C = (st & 1) * 32 + (swz % 64) / 2; }
__host__ __device__ __forceinline__ int perm32(int rho) { const int n = rho >> 4, i = rho & 15; return 8 * (i >> 2) + 4 * n + (i & 3); }

struct Unit { int pm, pn; size_t aoff, boff; int grow; };

DI void tile_order(int L, int nM, int nN, int& pm, int& pn) {
    const int nwg = nM * nN; int wgid = L;
    { const int q = nwg / NXCD, r = nwg % NXCD, xcd = wgid % NXCD, off = wgid / NXCD; wgid = (xcd < r ? xcd * (q + 1) : r * (q + 1) + (xcd - r) * q) + off; }
    const int nig = WGM * nN, gid = wgid / nig, fm = gid * WGM, gsz = (nM - fm) < WGM ? (nM - fm) : WGM;
    pm = fm + ((wgid % nig) % gsz); pn = (wgid % nig) / gsz;
}

typedef int v8i32 __attribute__((ext_vector_type(8)));
template <class Epi, class Sched, bool GATHER, bool FP8 = false>
__device__ __forceinline__ void gemm_phase(PG8_LAS unsigned char* lds, const void* A, const void* Bt, const int lda_e, const int ldb_e, const int K, const Sched& S, const Epi& E, const int* __restrict__ gtab) {
    constexpr int ESZ = FP8 ? 1 : 2; const int lda = lda_e * ESZ, ldb = ldb_e * ESZ;
    const int tid = opaque_tid(), wid = __builtin_amdgcn_readfirstlane(tid >> 6), lane = tid & 63, wr = wid >> 2, wc = wid & 3, fr = lane & 15, fq = lane >> 4;
    const int nt = K * ESZ / (BK * 2);
    unsigned voffA[2], voffB[2]; int stR[2], stC[2];
#pragma unroll
    for (int i = 0; i < 2; ++i) { int R, C; stage_rc(tid * 16 + i * 8192, R, C); const int Rb = Epi::PERM ? ((R & ~31) + perm32(R & 31)) : R;
        stR[i] = R; stC[i] = C; voffA[i] = (unsigned)(R * lda + C * 2); voffB[i] = (unsigned)(Rb * ldb + C * 2); }
    const size_t kstep = (size_t)(BK * 2);
    const size_t hstepA = (size_t)HALF * lda, hstepB = (size_t)HALF * ldb;
    const unsigned ldsw = (unsigned)wid * 1024u;
    int aoff = lds_byte(wr * 64 + fr, fq * 8); asm volatile("" : "+v"(aoff));
    int boff = lds_byte(wc * 32 + fr, fq * 8) + 4 * HTB;
    asm volatile("" : "+v"(boff));
#define PG8_SA(b, h) (((b) * 2 + (h)) * HTB)
#define PG8_SB(b, h) ((4 + (b) * 2 + (h)) * HTB)
#define PG8_SBR(b, h) (((b) * 2 + (h)) * HTB)
#define PG8_STAGE(bufoff, gbase, voff) do { _Pragma("unroll") for (int _i = 0; _i < 2; ++_i) { unsigned _vo = (voff)[_i]; asm volatile("" : "+v"(_vo)); \
        __builtin_amdgcn_global_load_lds((const unsigned*)((const char*)(gbase) + _vo), (PG8_LAS unsigned*)(lds + (bufoff) + ldsw + _i * 8192), 16, 0, 0); } } while (0)
#define PG8_STAGE_A(bufoff, p, h, go) do { if constexpr (GATHER) { _Pragma("unroll") for (int _i = 0; _i < 2; ++_i) { unsigned _vo = (go)[(h) * 2 + _i]; asm volatile("" : "+v"(_vo)); \
        __builtin_amdgcn_global_load_lds((const unsigned*)((const char*)(p) + _vo), (PG8_LAS unsigned*)(lds + (bufoff) + ldsw + _i * 8192), 16, 0, 0); } } \
        else { PG8_STAGE(bufoff, (p) + (h) * hstepA, voffA); } } while (0)
#define PG8_LD16(off) (*(const PG8_LAS v4u*)(lds + (off)))
#define PG8_LDA(dst, b, h) do { _Pragma("unroll") for (int m = 0; m < 4; ++m) dst[m] = __builtin_shufflevector(PG8_LD16(PG8_SA(b, h) + aoff + m * 2048), PG8_LD16(PG8_SA(b, h) + aoff + m * 2048 + 1024), 0, 1, 2, 3, 4, 5, 6, 7); } while (0)
#define PG8_LDB(dst, b, h) do { _Pragma("unroll") for (int n = 0; n < 2; ++n) dst[n] = __builtin_shufflevector(PG8_LD16(PG8_SBR(b, h) + boff + n * 2048), PG8_LD16(PG8_SBR(b, h) + boff + n * 2048 + 1024), 0, 1, 2, 3, 4, 5, 6, 7); } while (0)
#define PG8_HALF(x, k) __builtin_bit_cast(bf16x8, __builtin_shufflevector((x), (x), 4 * (k), 4 * (k) + 1, 4 * (k) + 2, 4 * (k) + 3))
#define PG8_MMA(ai, bj, At, Bt_) do { __builtin_amdgcn_s_setprio(1); _Pragma("unroll") for (int m = 0; m < 4; ++m) _Pragma("unroll") for (int n = 0; n < 2; ++n) { \
        if constexpr (FP8) acc[ai][bj][m][n] = __builtin_amdgcn_mfma_scale_f32_16x16x128_f8f6f4(__builtin_bit_cast(v8i32, Bt_[n]), __builtin_bit_cast(v8i32, At[m]), acc[ai][bj][m][n], 0, 0, 0, 0x7c7c7c7c, 0, 0x7c7c7c7c);   \
        else { acc[ai][bj][m][n] = __builtin_amdgcn_mfma_f32_16x16x32_bf16(PG8_HALF(Bt_[n], 0), PG8_HALF(At[m], 0), acc[ai][bj][m][n], 0, 0, 0); \
               acc[ai][bj][m][n] = __builtin_amdgcn_mfma_f32_16x16x32_bf16(PG8_HALF(Bt_[n], 1), PG8_HALF(At[m], 1), acc[ai][bj][m][n], 0, 0, 0); } } \
        __builtin_amdgcn_s_setprio(0); } while (0)
#define PG8_WAIT_V(n) asm volatile("s_waitcnt vmcnt(" #n ")" ::: "memory")
#define PG8_WAIT_L(n) asm volatile("s_waitcnt lgkmcnt(" #n ")" ::: "memory")
#define PG8_BAR __builtin_amdgcn_s_barrier()
#define PG8_SCHED __builtin_amdgcn_sched_barrier(0)
#define PG8_GOFF(dst, u) do { if constexpr (GATHER) { _Pragma("unroll") for (int _h = 0; _h < 2; ++_h) _Pragma("unroll") for (int _i = 0; _i < 2; ++_i) \
        dst[_h * 2 + _i] = (unsigned)(gtab[(u).grow + _h * HALF + stR[_i]] * lda + stC[_i] * 2); } } while (0)
    Unit cur, nxt; int ui = 0;
    if (!S.next(0, cur)) return;
    f32x4 acc[2][2][4][2];
#pragma unroll
    for (int a = 0; a < 2; ++a)
#pragma unroll
        for (int b = 0; b < 2; ++b)
#pragma unroll
            for (int m = 0; m < 4; ++m)
#pragma unroll
                for (int n = 0; n < 2; ++n) acc[a][b][m][n] = (f32x4){0.f, 0.f, 0.f, 0.f};
    typedef unsigned v8u __attribute__((ext_vector_type(8)));
    v8u At[4], B0[2], B1[2];
    unsigned gC[4] = {0u, 0u, 0u, 0u}, gN[4] = {0u, 0u, 0u, 0u};
    const char* cA = (const char*)A + cur.aoff; const char* cB = (const char*)Bt + cur.boff;
    PG8_GOFF(gC, cur);
    PG8_STAGE(PG8_SB(0, 0), cB, voffB); PG8_STAGE(PG8_SB(0, 1), cB + hstepB, voffB); PG8_STAGE_A(PG8_SA(0, 0), cA, 0, gC); PG8_STAGE_A(PG8_SA(0, 1), cA, 1, gC);
    if (wr == 1) PG8_BAR;
    PG8_WAIT_V(2); PG8_BAR;
    PG8_STAGE(PG8_SB(1, 0), cB + kstep, voffB); PG8_STAGE_A(PG8_SA(1, 0), cA + kstep, 0, gC); PG8_STAGE(PG8_SB(1, 1), cB + hstepB + kstep, voffB);
    PG8_WAIT_V(6); PG8_BAR;
    for (;;) {
        const bool has_next = S.next(ui + 1, nxt);
        const char* nA = has_next ? (const char*)A + nxt.aoff : cA; const char* nB = has_next ? (const char*)Bt + nxt.boff : cB;
        if constexpr (GATHER) { if (has_next) { PG8_GOFF(gN, nxt); } else {
#pragma unroll
            for (int q = 0; q < 4; ++q) gN[q] = gC[q]; } }
#pragma unroll 1
        for (int t = 0; t < nt; t += 2) {
            const bool last = (t == nt - 2);
            const char* a1 = cA + (size_t)(t + 1) * kstep;
            const char* a2 = last ? nA : cA + (size_t)(t + 2) * kstep; const char* b2 = last ? nB : cB + (size_t)(t + 2) * kstep;
            const char* a3 = a2 + kstep; const char* b3 = b2 + kstep;
            PG8_LDB(B0, 0, 0); PG8_LDB(B1, 0, 1); PG8_SCHED; PG8_LDA(At, 0, 0); PG8_STAGE_A(PG8_SA(1, 1), a1, 1, gC);
            if constexpr (GATHER) { if (last) {
#pragma unroll
                for (int q = 0; q < 4; ++q) gC[q] = gN[q]; } }
            PG8_WAIT_V(8); PG8_WAIT_L(0); PG8_BAR; PG8_MMA(0, 0, At, B0); PG8_MMA(0, 1, At, B1); PG8_BAR; PG8_SCHED;
            PG8_LDA(At, 0, 1); PG8_STAGE(PG8_SB(0, 0), b2, voffB); PG8_STAGE(PG8_SB(0, 1), b2 + hstepB, voffB); PG8_STAGE_A(PG8_SA(0, 0), a2, 0, gC);
            PG8_WAIT_V(8); PG8_WAIT_L(0); PG8_BAR; PG8_MMA(1, 0, At, B0); PG8_MMA(1, 1, At, B1); PG8_BAR; PG8_SCHED;
            PG8_LDB(B0, 1, 0); PG8_LDB(B1, 1, 1); PG8_SCHED; PG8_LDA(At, 1, 0); PG8_STAGE_A(PG8_SA(0, 1), a2, 1, gC);
            PG8_WAIT_V(8); PG8_WAIT_L(0); PG8_BAR; PG8_MMA(0, 0, At, B0); PG8_MMA(0, 1, At, B1); PG8_BAR; PG8_SCHED;
            PG8_LDA(At, 1, 1); PG8_STAGE(PG8_SB(1, 0), b3, voffB); PG8_STAGE(PG8_SB(1, 1), b3 + hstepB, voffB); PG8_STAGE_A(PG8_SA(1, 0), a3, 0, gC);
            PG8_WAIT_V(8); PG8_WAIT_L(0); PG8_BAR; PG8_MMA(1, 0, At, B0); PG8_MMA(1, 1, At, B1); PG8_BAR; PG8_SCHED;
        }
        if (wr == 0) PG8_BAR;
        { const int le = fresh_lane(); E(acc, cur, wr, wc, le & 15, le >> 4); }
        if (!has_next) break;
#pragma unroll
        for (int a = 0; a < 2; ++a)
#pragma unroll
            for (int b = 0; b < 2; ++b)
#pragma unroll
                for (int m = 0; m < 4; ++m)
#pragma unroll
                    for (int n = 0; n < 2; ++n) acc[a][b][m][n] = (f32x4){0.f, 0.f, 0.f, 0.f};
        cur = nxt; cA = nA; cB = nB; ++ui;
        if (wr == 1) PG8_BAR;
    }
    PG8_WAIT_V(0);
    PG8_BAR;
#undef PG8_SA
#undef PG8_SB
#undef PG8_SBR
#undef PG8_STAGE
#undef PG8_STAGE_A
#undef PG8_LDA
#undef PG8_LDB
#undef PG8_MMA
#undef PG8_HALF
#undef PG8_LD16
#undef PG8_WAIT_V
#undef PG8_WAIT_L
#undef PG8_BAR
#undef PG8_SCHED
#undef PG8_GOFF
}
}

namespace pg8 {
DI v4u pack8(const f32x4& v0, const f32x4& v1) { v4u w; w.x = cvt_pk_bf16(v0[0], v0[1]); w.y = cvt_pk_bf16(v0[2], v0[3]); w.z = cvt_pk_bf16(v1[0], v1[1]); w.w = cvt_pk_bf16(v1[2], v1[3]); return w; }
DI void unpack8(const v4u w, f32x4& v0, f32x4& v1) { v0 = (f32x4){bf_lo(w.x), bf_hi(w.x), bf_lo(w.y), bf_hi(w.y)}; v1 = (f32x4){bf_lo(w.z), bf_hi(w.z), bf_lo(w.w), bf_hi(w.w)}; }

struct SchedA1 {
    int G, c; size_t esz;
    DI bool next(int i, Unit& u) const {
        const long L = (long)i * G + c; const int n1 = 132 * 12, n2 = 132 * 2, n3 = 128 * 4;
        if (L >= n1 + n2 + n3) return false;
        int pm, pn;
        if (L < n1) { tile_order((int)L, 132, 12, pm, pn); pn += 4; }
        else if (L < n1 + n2) { tile_order((int)L - n1, 132, 2, pm, pn); pn += 28; }
        else { int pl; tile_order((int)L - n1 - n2, 128, 4, pl, pn); pm = (pl >> 5) * TPB + 1 + (pl & 31); }
        u.pm = pm; u.pn = pn; u.aoff = (size_t)pm * 256 * DM * esz; u.boff = (size_t)pn * 256 * DM * esz; u.grow = 0; return true;
    }
};
struct EpiA1 {
    static constexpr bool PERM = true;
    bf16 *QR, *KR, *VR, *KA, *VA; const float *cosr, *sinr;
    DI void operator()(const f32x4 (&acc)[2][2][4][2], const Unit& u, int wr, int wc, int fr, int fq) const {
        const int pn = u.pn; const int tin = u.pm % TPB;
        if (pn >= 8) {
            const int ldc = pn >= 28 ? 256 : 2048;
            bf16* base = (pn == 28 ? KA : (pn == 29 ? VA : VR + (pn - 8) * 256)) + (size_t)(u.pm * 256 + wr * 64 + fr) * ldc + wc * 32 + 8 * fq;
#pragma unroll
            for (int ai = 0; ai < 2; ++ai)
#pragma unroll
                for (int m = 0; m < 4; ++m)
#pragma unroll
                    for (int bj = 0; bj < 2; ++bj) __builtin_nontemporal_store(pack8(acc[ai][bj][m][0], acc[ai][bj][m][1]), (v4u*)(base + (size_t)(ai * 128 + m * 16) * ldc + bj * 128));
            return;
        }
        const bool isk = pn >= 4; const float sc = isk ? 0.0625f : 1.0f; const bool rope = tin != 0;
        const int hd = pn & 3, R0 = u.pm * 256 + wr * 64 + fr;
        const int axis = wc >> 1, f0 = 32 * (wc & 1) + 8 * fq;
#pragma unroll
        for (int ai = 0; ai < 2; ++ai)
#pragma unroll
            for (int m = 0; m < 4; ++m) {
                f32x4 o1[2], o2[2];
                if (rope) {
                    const int t = (tin - 1) * 256 + ai * 128 + wr * 64 + m * 16 + fr;
                    const int pos = axis ? (t & 63) : (t >> 6);
#pragma unroll
                    for (int n = 0; n < 2; ++n) {
                        const f32x4 cs = *(const f32x4*)(cosr + pos * 64 + f0 + 4 * n), sn = *(const f32x4*)(sinr + pos * 64 + f0 + 4 * n);
                        const f32x4 x1 = acc[ai][0][m][n], x2 = acc[ai][1][m][n];
                        o1[n] = (x1 * cs - x2 * sn) * sc; o2[n] = (x2 * cs + x1 * sn) * sc;
                    }
                } else {
#pragma unroll
                    for (int n = 0; n < 2; ++n) { o1[n] = acc[ai][0][m][n] * sc; o2[n] = acc[ai][1][m][n] * sc; }
                }
                const int R = R0 + ai * 128 + m * 16;
                if (isk) { bf16* rp = KR + ((size_t)((R >> 6) * 4 + hd) * 2) * 8192 + ((4 * wc + fq) * 64 + (R & 63)) * 8;
                    __builtin_nontemporal_store(pack8(o1[0], o1[1]), (v4u*)(rp)); __builtin_nontemporal_store(pack8(o2[0], o2[1]), (v4u*)(rp + 8192)); }
                else { bf16* rp = QR + (size_t)((R >> 5) * 4 + hd) * 8192 + ((2 * wc + (fq >> 1)) * 64 + (fq & 1) * 32 + (R & 31)) * 8;
                    __builtin_nontemporal_store(pack8(o1[0], o1[1]), (v4u*)(rp)); __builtin_nontemporal_store(pack8(o2[0], o2[1]), (v4u*)(rp + 8 * 64 * 8)); }
            }
    }
};

struct SchedB1 {
    int G, c; size_t esz;
    DI bool next(int i, Unit& u) const {
        const long L = (long)i * G + c; const int n1 = 128 * 20;
        if (L >= n1) return false;
        int pm, pn;
        { int pl; tile_order((int)L, 128, 20, pl, pn); pm = (pl >> 5) * TPB + 1 + (pl & 31); if (pn >= 12) pn += 2; }
        u.pm = pm; u.pn = pn; u.aoff = (size_t)pm * 256 * DM * esz; u.boff = (size_t)pn * 256 * DM * esz; u.grow = 0; return true;
    }
};
DI size_t gt_frag_off(int pm, int pnl, int wr, int wc, int fr, int fq) { return ((size_t)((pm * 4 + pnl) * 8 + wr * 4 + wc) * 16) * 512 + (size_t)(fq * 16 + fr) * 8; }
struct EpiB1 {
    static constexpr bool PERM = true;
    bf16 *GR, *QA, *KA, *VA, *GTR, *GTA;
    DI void operator()(const f32x4 (&acc)[2][2][4][2], const Unit& u, int wr, int wc, int fr, int fq) const {
        const int pn = u.pn; bf16* dst; int ldc, col0, act;
        if (pn < 8) { dst = GR; ldc = 2048; col0 = pn * 256; act = 1; }
        else if (pn < 12) { dst = QA; ldc = 1024; col0 = (pn - 8) * 256; act = 0; }
        else if (pn == 12) { dst = KA; ldc = 256; col0 = 0; act = 0; }
        else if (pn == 13) { dst = VA; ldc = 256; col0 = 0; act = 0; }
        else if (pn < 18) { dst = GTR; ldc = 1024; col0 = (pn - 14) * 256; act = 2; }
        else { dst = GTA; ldc = 1024; col0 = (pn - 18) * 256; act = 2; }
        bf16* base = dst + (size_t)(u.pm * 256 + wr * 64 + fr) * ldc + col0 + wc * 32 + 8 * fq;
#pragma unroll
        for (int ai = 0; ai < 2; ++ai)
#pragma unroll
            for (int m = 0; m < 4; ++m)
#pragma unroll
                for (int bj = 0; bj < 2; ++bj) {
                    f32x4 v0 = acc[ai][bj][m][0], v1 = acc[ai][bj][m][1];
                    if (act) {
#pragma unroll
                        for (int j = 0; j < 4; ++j) { const float s0 = fast_sigmoid(v0[j]), s1 = fast_sigmoid(v1[j]); v0[j] = act == 1 ? v0[j] * s0 : s0; v1[j] = act == 1 ? v1[j] * s1 : s1; }
                    }
                    if (act == 2) { v2u q; q.x = pk4_fp8(v0[0], v0[1], v0[2], v0[3]); q.y = pk4_fp8(v1[0], v1[1], v1[2], v1[3]);
                        __builtin_nontemporal_store(q, (v2u*)((unsigned char*)dst + gt_frag_off(u.pm, (pn - 14) & 3, wr, wc, fr, fq) + (size_t)(ai * 8 + m * 2 + bj) * 512)); }
                    else __builtin_nontemporal_store(pack8(v0, v1), (v4u*)(base + (size_t)(ai * 128 + m * 16) * ldc + bj * 128));
                }
    }
};

struct SchedLat {
    int G, c, lda, ldb;
    DI bool next(int i, Unit& u) const {
        const long L = (long)i * G + c; if (L >= 128 * 4) return false;
        int pl, pn; tile_order((int)L, 128, 4, pl, pn); const int pm = (pl >> 5) * TPB + 1 + (pl & 31);
        u.pm = pm; u.pn = pn; u.aoff = (size_t)pm * 256 * lda; u.boff = (size_t)pn * 256 * ldb; u.grow = pl; return true;
    }
};
template <bool ADD> struct EpiGate {
    static constexpr bool PERM = true;
    bf16* Y; const unsigned char* Gt; unsigned char* Y8;
    DI void operator()(const f32x4 (&acc)[2][2][4][2], const Unit& u, int wr, int wc, int fr, int fq) const {
        const size_t off0 = (size_t)(u.pm * 256 + wr * 64 + fr) * 1024 + u.pn * 256 + wc * 32 + 8 * fq, goff0 = gt_frag_off(u.pm, u.pn, wr, wc, fr, fq);
#pragma unroll
        for (int ai = 0; ai < 2; ++ai) {
            v2u gq[4][2]; v4u yq[4][2];
#pragma unroll
            for (int m = 0; m < 4; ++m)
#pragma unroll
                for (int bj = 0; bj < 2; ++bj) { const size_t off = off0 + (size_t)(ai * 128 + m * 16) * 1024 + bj * 128; gq[m][bj] = *(const v2u*)(Gt + goff0 + (size_t)(ai * 8 + m * 2 + bj) * 512); if (ADD) yq[m][bj] = *(const v4u*)(Y + goff0 + (size_t)(ai * 8 + m * 2 + bj) * 512); }
#pragma unroll
            for (int m = 0; m < 4; ++m)
#pragma unroll
                for (int bj = 0; bj < 2; ++bj) {
                    const size_t off = off0 + (size_t)(ai * 128 + m * 16) * 1024 + bj * 128;
                    f32x4 g0, g1; { const auto l0 = __builtin_amdgcn_cvt_pk_f32_fp8((int)gq[m][bj].x, false), h0 = __builtin_amdgcn_cvt_pk_f32_fp8((int)gq[m][bj].x, true), l1 = __builtin_amdgcn_cvt_pk_f32_fp8((int)gq[m][bj].y, false), h1 = __builtin_amdgcn_cvt_pk_f32_fp8((int)gq[m][bj].y, true);
                        g0 = (f32x4){l0[0], l0[1], h0[0], h0[1]}; g1 = (f32x4){l1[0], l1[1], h1[0], h1[1]}; }
                    f32x4 v0 = acc[ai][bj][m][0] * g0, v1 = acc[ai][bj][m][1] * g1;
                    if (ADD) { f32x4 y0, y1; unpack8(yq[m][bj], y0, y1); v0 = (v0 + y0) * 4.0f; v1 = (v1 + y1) * 4.0f; v2u q;
#define YQ(v) __builtin_amdgcn_fmed3f((v), -448.f, 448.f)
                        q.x = pk4_fp8(YQ(v0[0]), YQ(v0[1]), YQ(v0[2]), YQ(v0[3])); q.y = pk4_fp8(YQ(v1[0]), YQ(v1[1]), YQ(v1[2]), YQ(v1[3]));
#undef YQ
                        *(v2u*)(Y8 + off) = q; }
                    else *(v4u*)(Y + goff0 + (size_t)(ai * 8 + m * 2 + bj) * 512) = pack8(v0, v1);
                }
            asm volatile("" ::: "memory");
        }
    }
};
struct EpiOut {
    static constexpr bool PERM = false;
    const float* x; float* out; const float* mod; int half;
    DI void operator()(const f32x4 (&acc)[2][2][4][2], const Unit& u, int wr, int wc, int fr, int fq) const {
        const int pl = u.grow, b = half * NBH + (pl >> 5); const size_t tok0 = (size_t)b * SEQ + (size_t)(pl & 31) * 256 + wr * 64 + fr;
        const int col0 = u.pn * 256 + wc * 32 + 4 * fq; const float* g1 = mod + (size_t)b * 6144 + 2048 + col0;
        f32x4 gv[2][2];
#pragma unroll
        for (int bj = 0; bj < 2; ++bj)
#pragma unroll
            for (int n = 0; n < 2; ++n) gv[bj][n] = *(const f32x4*)(g1 + bj * 128 + n * 16);
#pragma unroll
        for (int ai = 0; ai < 2; ++ai)
#pragma unroll
            for (int mp = 0; mp < 2; ++mp) {
                f32x4 xq[2][2][2];
#pragma unroll
                for (int mm = 0; mm < 2; ++mm) { const size_t off = (tok0 + ai * 128 + (2 * mp + mm) * 16) * DM + col0;
#pragma unroll
                    for (int bj = 0; bj < 2; ++bj)
#pragma unroll
                        for (int n = 0; n < 2; ++n) xq[mm][bj][n] = *(const f32x4*)(x + off + bj * 128 + n * 16); }
#pragma unroll
                for (int mm = 0; mm < 2; ++mm) { const int m = 2 * mp + mm; const size_t off = (tok0 + ai * 128 + m * 16) * DM + col0;
#pragma unroll
                    for (int bj = 0; bj < 2; ++bj)
#pragma unroll
                        for (int n = 0; n < 2; ++n) *(f32x4*)(out + off + bj * 128 + n * 16) = xq[mm][bj][n] + gv[bj][n] * acc[ai][bj][m][n]; }
                asm volatile("" ::: "memory"); }
    }
};

struct SchedMoe {
    int G, c, ncol; const int* tileb; size_t b_exp_stride  , ldb  , lda  ; bool gather;
    DI bool next(int i, Unit& u) const {
        const int ntile = tileb[32]; const long L = (long)i * G + c; if (L >= (long)ntile * ncol) return false;
        const int rt = (int)(L / ncol), pn = (int)(L % ncol); const int e = tileb[64 + rt];
        u.pm = rt; u.pn = pn; u.grow = rt * 256; u.aoff = gather ? 0 : (size_t)rt * 256 * lda; u.boff = (size_t)e * b_exp_stride + (size_t)pn * 256 * ldb; return true;
    }
};
DI int moe_expert_of_tile(const int* tileb, int rt) { return tileb[64 + rt]; }
struct EpiSwiglu {
    static constexpr bool PERM = true;
    unsigned char* ACT; const float* b1; const int* tileb;
    DI void operator()(const f32x4 (&acc)[2][2][4][2], const Unit& u, int wr, int wc, int fr, int fq) const {
        const int e = moe_expert_of_tile(tileb, u.pm); const int cg = u.pn * 128 + wc * 32 + 8 * fq;
        const float* bp = b1 + (size_t)e * 2048 + cg;
        const f32x4 bg0 = *(const f32x4*)(bp), bg1 = *(const f32x4*)(bp + 4), bu0 = *(const f32x4*)(bp + 1024), bu1 = *(const f32x4*)(bp + 1028);
        unsigned char* base = ACT + (size_t)(u.pm * 256 + wr * 64 + fr) * 1024 + cg;
#pragma unroll
        for (int ai = 0; ai < 2; ++ai)
#pragma unroll
            for (int m = 0; m < 4; ++m) {
                f32x4 g0 = acc[ai][0][m][0] + bg0, g1 = acc[ai][0][m][1] + bg1, u0 = acc[ai][1][m][0] + bu0, u1 = acc[ai][1][m][1] + bu1;
#pragma unroll
                for (int j = 0; j < 4; ++j) {
                    const float ga = fminf(g0[j], 7.0f), gb = fminf(g1[j], 7.0f);
                    const float ua = fminf(fmaxf(u0[j], -7.0f), 7.0f), ub = fminf(fmaxf(u1[j], -7.0f), 7.0f);
                    g0[j] = 4.0f * ga * fast_sigmoid(1.702f * ga) * (ua + 1.0f); g1[j] = 4.0f * gb * fast_sigmoid(1.702f * gb) * (ub + 1.0f);
                }
                v2u w; w.x = pk4_fp8(g0[0], g0[1], g0[2], g0[3]); w.y = pk4_fp8(g1[0], g1[1], g1[2], g1[3]);
                __builtin_nontemporal_store(w, (v2u*)(base + (size_t)(ai * 128 + m * 16) * 1024));
                asm volatile("" ::: "memory");
            }
    }
};
struct EpiDown {
    static constexpr bool PERM = true;
    bf16* Y2; const float* b2; const int* tileb; const float* roww;
    DI void operator()(const f32x4 (&acc)[2][2][4][2], const Unit& u, int wr, int wc, int fr, int fq) const {
        const int e = moe_expert_of_tile(tileb, u.pm); const int c0 = u.pn * 256 + wc * 32 + 8 * fq;
        f32x4 bv[2][2];
#pragma unroll
        for (int bj = 0; bj < 2; ++bj)
#pragma unroll
            for (int n = 0; n < 2; ++n) bv[bj][n] = *(const f32x4*)(b2 + (size_t)e * 1024 + c0 + bj * 128 + 4 * n);
        float wq[2][4];
#pragma unroll
        for (int ai = 0; ai < 2; ++ai)
#pragma unroll
            for (int m = 0; m < 4; ++m) wq[ai][m] = roww[u.pm * 256 + ai * 128 + wr * 64 + m * 16 + fr];
        bf16* base = Y2 + (size_t)(u.pm * 256 + wr * 64 + fr) * 1024 + c0;
#pragma unroll
        for (int ai = 0; ai < 2; ++ai)
#pragma unroll
            for (int m = 0; m < 4; ++m) { const float w = wq[ai][m];
#pragma unroll
                for (int bj = 0; bj < 2; ++bj) __builtin_nontemporal_store(pack8((acc[ai][bj][m][0] + bv[bj][0]) * w, (acc[ai][bj][m][1] + bv[bj][1]) * w), (v4u*)(base + (size_t)(ai * 128 + m * 16) * 1024 + bj * 128));
            }
    }
};
}

namespace att {
constexpr int D = 128, NW = 8, QBLK = 32, KVBLK = 64;
constexpr float SCALE = 0.088388347648318440f;
constexpr float THR = 1.9f;
constexpr float PSH = 6.f;
constexpr float QSC = SCALE * 1.4426950408889634f;
constexpr float THR2 = THR * 1.4426950408889634f;
constexpr float VSC = 8.f;
constexpr int LDQ = 1024, LDK = 256, LDO = 1024;
constexpr size_t SHM_V = KVBLK * D, SHM_K = KVBLK * D, SLOT = SHM_K + SHM_V, SHM_ATTN = 8 * SLOT;
typedef int v8i32 __attribute__((ext_vector_type(8)));
#define KSWZ(row, colB) ((row) * 128 + ((colB) ^ ((((row) >> 1) & 7) << 4)))
#define SBAR() __builtin_amdgcn_sched_barrier(0)
DI int crow(int r, int hi) { return (r & 3) + 8 * (r >> 2) + 4 * hi; }
DI unsigned cvtpk(float lo, float hi) { unsigned r; asm volatile("v_cvt_pk_bf16_f32 %0, %1, %2" : "=v"(r) : "v"(lo), "v"(hi)); return r; }

DI void head_tile0(f32x16& p0, f32x16& p1, f32x16& nm, const char* Ks, const v8i32* qf, int r32, int hi) {
  p0 = f32x16{}; p1 = f32x16{};
#pragma unroll
  for (int c = 0; c < 2; ++c) { const int cb = c * 64 + hi * 32;
    const v4u a0 = *reinterpret_cast<const v4u*>(Ks + KSWZ(r32, cb)), a1 = *reinterpret_cast<const v4u*>(Ks + KSWZ(r32, cb + 16));
    const v4u b0 = *reinterpret_cast<const v4u*>(Ks + KSWZ(32 + r32, cb)), b1 = *reinterpret_cast<const v4u*>(Ks + KSWZ(32 + r32, cb + 16));
    const v8i32 ka = {(int)a0.x, (int)a0.y, (int)a0.z, (int)a0.w, (int)a1.x, (int)a1.y, (int)a1.z, (int)a1.w};
    const v8i32 kb = {(int)b0.x, (int)b0.y, (int)b0.z, (int)b0.w, (int)b1.x, (int)b1.y, (int)b1.z, (int)b1.w};
    p0 = __builtin_amdgcn_mfma_scale_f32_32x32x64_f8f6f4(ka, qf[c], p0, 0, 0, 0, 0, 0, 0);
    p1 = __builtin_amdgcn_mfma_scale_f32_32x32x64_f8f6f4(kb, qf[c], p1, 0, 0, 0, 0, 0, 0); }
  float pmax = p0[0]; for (int r = 1; r < 16; ++r) pmax = fmaxf(pmax, p0[r]); for (int r = 0; r < 16; ++r) pmax = fmaxf(pmax, p1[r]);
  { auto rr = __builtin_amdgcn_permlane32_swap(__float_as_uint(pmax), __float_as_uint(pmax), false, false);
    pmax = fmaxf(__uint_as_float(rr[0]), __uint_as_float(rr[1])); }
  const float nmv = PSH - pmax;
  for (int r = 0; r < 16; ++r) { nm[r] = nmv; p0[r] = __builtin_amdgcn_exp2f(p0[r] + nmv); p1[r] += nmv; }
}
DI void finishSM(f32x16& p0, f32x16& p1, v8i32& pb) {
  for (int r = 0; r < 16; ++r) p1[r] = __builtin_amdgcn_exp2f(p1[r]);
#pragma unroll
  for (int w = 0; w < 4; ++w) { pb[w] = (int)pk4_fp8(p0[4 * w], p0[4 * w + 1], p0[4 * w + 2], p0[4 * w + 3]); pb[4 + w] = (int)pk4_fp8(p1[4 * w], p1[4 * w + 1], p1[4 * w + 2], p1[4 * w + 3]); }
}
DI void pv8(f32x16* o, const char* Vs, int va, const v8i32& pb) {
#pragma unroll
  for (int db = 0; db < 4; ++db) {
    const v4u x0 = *reinterpret_cast<const v4u*>(Vs + db * 2048 + va), x1 = *reinterpret_cast<const v4u*>(Vs + db * 2048 + (va ^ 16));
    const v8i32 vt = {(int)x0.x, (int)x0.y, (int)x0.z, (int)x0.w, (int)x1.x, (int)x1.y, (int)x1.z, (int)x1.w};
    o[db] = __builtin_amdgcn_mfma_scale_f32_32x32x64_f8f6f4(vt, pb, o[db], 0, 0, 0, 0, 0, 0); }
}

DI v8i32 krd(const char* Ks, int row, int cb) { const v4u a = *reinterpret_cast<const v4u*>(Ks + KSWZ(row, cb)), b = *reinterpret_cast<const v4u*>(Ks + KSWZ(row, cb + 16));
  return v8i32{(int)a.x, (int)a.y, (int)a.z, (int)a.w, (int)b.x, (int)b.y, (int)b.z, (int)b.w}; }
DI v8i32 vrd(const char* Vs, int db, int va) { const v4u a = *reinterpret_cast<const v4u*>(Vs + db * 2048 + va), b = *reinterpret_cast<const v4u*>(Vs + db * 2048 + (va ^ 16));
  return v8i32{(int)a.x, (int)a.y, (int)a.z, (int)a.w, (int)b.x, (int)b.y, (int)b.z, (int)b.w}; }
#define MF8(a, b, c) __builtin_amdgcn_mfma_scale_f32_32x32x64_f8f6f4(a, b, c, 0, 0, 0, 0, 0, 0)
DI v8i32 mkones() { v8i32 o; for (int w = 0; w < 8; ++w) { int x_; asm volatile("v_mov_b32 %0, 0x38383838" : "=v"(x_)); o[w] = x_; } return o; }
#ifdef DIAG_ATT
#define ATT_ONES mkones()
#else
#define ATT_ONES ones
#endif
#define ANCH(x) asm volatile("" : "+v"(x))
#define MFS(a, b, c) __builtin_amdgcn_mfma_scale_f32_32x32x64_f8f6f4(a, b, c, 0, 0, 0, 0, 0, 0)
#define PKC(dst, P, w) do { int t_ = __builtin_amdgcn_cvt_pk_fp8_f32(P[4 * (w)], P[4 * (w) + 1], dst, false); dst = __builtin_amdgcn_cvt_pk_fp8_f32(P[4 * (w) + 2], P[4 * (w) + 3], t_, true); } while (0)
#define ATT_STEP(pC0, pC1, alC, pN0, pN1, alN, KB, VB) do {                                                                                            \
    SBAR(); const v8i32 k0_ = krd(KB, r32, hi * 32), k1_ = krd(KB, 32 + r32, hi * 32);                                                                  \
    SBAR(); pN0 = MFS(k0_, qf[0], nm);                                                                                                                  \
    SBAR(); for (int r = 0; r < 8; ++r) pC1[r] = __builtin_amdgcn_exp2f(pC1[r]);                                                                       \
    const v8i32 k2_ = krd(KB, r32, 64 + hi * 32), k3_ = krd(KB, 32 + r32, 64 + hi * 32); ANCH(pC1);                                                     \
    SBAR(); pN1 = MFS(k1_, qf[0], nm);                                                                                                                  \
    SBAR(); for (int r = 8; r < 16; ++r) pC1[r] = __builtin_amdgcn_exp2f(pC1[r]); ANCH(pC1);                                                           \
    SBAR(); pN0 = MFS(k2_, qf[1], pN0);                                                                                                                 \
    SBAR(); PKC(pb[0], pC0, 0); PKC(pb[1], pC0, 1); PKC(pb[2], pC0, 2); PKC(pb[3], pC0, 3);                                                                     \
    SBAR(); pN1 = MFS(k3_, qf[1], pN1);                                                                                                                 \
    SBAR(); PKC(pb[4], pC1, 0); PKC(pb[5], pC1, 1); PKC(pb[6], pC1, 2); PKC(pb[7], pC1, 3);                                                                     \
    const v8i32 v0_ = vrd(VB, 0, va), v1_ = vrd(VB, 1, va);                                                                                             \
    SBAR(); o[0] = MF8(v0_, pb, o[0]);                                                                                                                  \
    SBAR(); pC0 = MF8(ATT_ONES, pb, f32x16{});     \
    SBAR(); float pm_ = fmaxf(pN0[0], pN1[0]); for (int r = 1; r < 16; ++r) pm_ = fmaxf(fmaxf(pm_, pN0[r]), pN1[r]);                                   \
    { auto rr = __builtin_amdgcn_permlane32_swap(__float_as_uint(pm_), __float_as_uint(pm_), false, false); pm_ = fmaxf(__uint_as_float(rr[0]), __uint_as_float(rr[1])); } \
    const v8i32 v2_ = vrd(VB, 2, va), v3_ = vrd(VB, 3, va); alN = 1.f;                                                                                  \
    if (__builtin_expect(!__all(pm_ - PSH <= THR2), 0)) { const float dl_ = fmaxf(pm_ - PSH, 0.f); alN = __builtin_amdgcn_exp2f(-dl_);                  \
      for (int r = 0; r < 16; ++r) { pN0[r] -= dl_; pN1[r] -= dl_; nm[r] -= dl_; } }                                                                    \
    SBAR(); o[1] = MF8(v1_, pb, o[1]);                                                                                                                  \
    SBAR(); for (int r = 0; r < 8; ++r) pN0[r] = __builtin_amdgcn_exp2f(pN0[r]); ANCH(pN0);                                                            \
    SBAR(); o[2] = MF8(v2_, pb, o[2]);                                                                                                                  \
    SBAR(); for (int r = 8; r < 16; ++r) pN0[r] = __builtin_amdgcn_exp2f(pN0[r]); ANCH(pN0);                                                           \
    SBAR(); o[3] = MF8(v3_, pb, o[3]);                                                                                                                  \
    SBAR(); l_reg = l_reg * alC + pC0[0]; ANCH(l_reg);                                                                                                  \
    SBAR(); } while (0)

DI void attn_dense_body(const bf16* Qb, const unsigned char* __restrict__ K8h, const unsigned char* __restrict__ V8h, bf16* Ob, unsigned char* O8b, int seq, LAS unsigned char* ldsl,
                        int tpos0, const float* __restrict__ qn, const float* __restrict__ cosa, const float* __restrict__ sina) {
  const int tid = opaque_tid(), wid = tid >> 6, lane = tid & 63, r32 = lane & 31, hi = lane >> 5;
  const char* lds = (const char*)ldsl;
  f32x16 o[4] = {}; f32x16 nm; v8i32 qf[2]; float l_reg = 0.f;
  v8i32 ones;
#pragma unroll
  for (int w = 0; w < 8; ++w) { int x_; asm volatile("v_mov_b32 %0, 0x38383838" : "=v"(x_)); ones[w] = x_; }
  char* const ldsw = (char*)ldsl;
  v4u st_k, st_v;
#define SLOAD(t_) do { st_k = *reinterpret_cast<const v4u*>(K8h + (long)(t_) * 8192 + tid * 16); st_v = *reinterpret_cast<const v4u*>(V8h + (long)(t_) * 8192 + tid * 16); } while (0)
#define SWRITE(t_) do { *reinterpret_cast<v4u*>(ldsw + ((t_) & 7) * (int)SLOT + tid * 16) = st_k; *reinterpret_cast<v4u*>(ldsw + ((t_) & 7) * (int)SLOT + (int)SHM_K + tid * 16) = st_v; } while (0)
  const v4u pk0_ = *reinterpret_cast<const v4u*>(K8h + tid * 16), pv0_ = *reinterpret_cast<const v4u*>(V8h + tid * 16);
  const v4u pk1_ = *reinterpret_cast<const v4u*>(K8h + 8192 + tid * 16), pv1_ = *reinterpret_cast<const v4u*>(V8h + 8192 + tid * 16);
  SLOAD(2);
  {
    const bf16* Qw = Qb + (long)(wid * QBLK + r32) * LDQ;
    float ss = 0.f;
#pragma unroll
    for (int d0 = 0; d0 < 8; ++d0) { const v4u w = *reinterpret_cast<const v4u*>(Qw + d0 * 16 + hi * 8);
      const float a0 = bf_lo(w.x), a1 = bf_hi(w.x), a2 = bf_lo(w.y), a3 = bf_hi(w.y), a4 = bf_lo(w.z), a5 = bf_hi(w.z), a6 = bf_lo(w.w), a7 = bf_hi(w.w);
      ss += (a0 * a0 + a1 * a1) + (a2 * a2 + a3 * a3) + (a4 * a4 + a5 * a5) + (a6 * a6 + a7 * a7); }
    { auto rr = __builtin_amdgcn_permlane32_swap(__float_as_uint(ss), __float_as_uint(ss), false, false); ss = __uint_as_float(rr[0]) + __uint_as_float(rr[1]); }
    const float rstd = 1.0f / sqrtf(ss * (1.0f / 128.0f) + EPS);
    const int t = tpos0 + wid * QBLK + r32;
#pragma unroll
    for (int a = 0; a < 2; ++a) { const int pos = a ? (t & 63) : (t >> 6);
#pragma unroll
      for (int g = 0; g < 4; ++g) {
        const v4u wa = *reinterpret_cast<const v4u*>(Qw + 64 * a + 8 * g), wb = *reinterpret_cast<const v4u*>(Qw + 64 * a + 32 + 8 * g);
        float x1[8] = {bf_lo(wa.x), bf_hi(wa.x), bf_lo(wa.y), bf_hi(wa.y), bf_lo(wa.z), bf_hi(wa.z), bf_lo(wa.w), bf_hi(wa.w)};
        float x2[8] = {bf_lo(wb.x), bf_hi(wb.x), bf_lo(wb.y), bf_hi(wb.y), bf_lo(wb.z), bf_hi(wb.z), bf_lo(wb.w), bf_hi(wb.w)};
        float oo[8];
#pragma unroll
        for (int j = 0; j < 8; ++j) { const float g1 = qn[64 * a + 8 * g + j] * rstd, g2 = qn[64 * a + 32 + 8 * g + j] * rstd; const float cs = cosa[pos * 32 + 8 * g + j], sn = sina[pos * 32 + 8 * g + j];
          const float y1 = x1[j] * g1, y2 = x2[j] * g2; const float v = hi ? (y2 * cs + y1 * sn) : (y1 * cs - y2 * sn); oo[j] = __builtin_amdgcn_fmed3f(v * QSC, -448.f, 448.f); }
        qf[a][2 * g] = (int)pk4_fp8(oo[0], oo[1], oo[2], oo[3]); qf[a][2 * g + 1] = (int)pk4_fp8(oo[4], oo[5], oo[6], oo[7]); } }
  }
  const int va = r32 * 64 + (((2 * hi) ^ ((r32 >> 2) & 3)) << 4);
#define RESC(a) do { if (__any((a) < 1.f)) { for (int d = 0; d < 4; ++d) for (int r = 0; r < 16; ++r) o[d][r] *= (a); } } while (0)
#define KSLOT(t_) (lds + ((t_) & 7) * (int)SLOT)
#define VSLOT(t_) (lds + ((t_) & 7) * (int)SLOT + (int)SHM_K)
  f32x16 pA0, pA1, pB0, pB1; float alA = 1.f, alB; v8i32 pb = {0, 0, 0, 0, 0, 0, 0, 0}; const int NT = seq / KVBLK;
  *reinterpret_cast<v4u*>(ldsw + tid * 16) = pk0_; *reinterpret_cast<v4u*>(ldsw + (int)SHM_K + tid * 16) = pv0_;
  *reinterpret_cast<v4u*>(ldsw + (int)SLOT + tid * 16) = pk1_; *reinterpret_cast<v4u*>(ldsw + (int)SLOT + (int)SHM_K + tid * 16) = pv1_;
  SWRITE(2); __syncthreads();
  head_tile0(pA0, pA1, nm, KSLOT(0), qf, r32, hi);
  for (int t = 0; t + 2 < NT; t += 2) {
    if (t + 3 < NT) SLOAD(t + 3); RESC(alA);
    ATT_STEP(pA0, pA1, alA, pB0, pB1, alB, KSLOT(t + 1), VSLOT(t));
    if (t + 3 < NT) SWRITE(t + 3);
    if (t + 4 < NT) SLOAD(t + 4); RESC(alB);
    ATT_STEP(pB0, pB1, alB, pA0, pA1, alA, KSLOT(t + 2), VSLOT(t + 1));
    if (t + 4 < NT) SWRITE(t + 4); __syncthreads();
  }
  RESC(alA);
  ATT_STEP(pA0, pA1, alA, pB0, pB1, alB, KSLOT(NT - 1), VSLOT(NT - 2));
  RESC(alB);
  finishSM(pB0, pB1, pb); SBAR();
  pv8(o, VSLOT(NT - 1), va, pb); pB0 = MF8(ATT_ONES, pb, f32x16{}); l_reg = l_reg * alB + pB0[0];
  const float rl = __builtin_amdgcn_rcpf(l_reg) * (1.0f / VSC);
  const int tid2 = opaque_tid();
#ifdef DIAG_ATT
  bf16* Ow = Ob + (long)((tid2 >> 6) * QBLK + (tid2 & 31)) * LDO + 4 * ((tid2 >> 5) & 1);
#pragma unroll
  for (int db = 0; db < 4; ++db)
#pragma unroll
    for (int r4 = 0; r4 < 4; ++r4) { v2u w; w.x = cvtpk(o[db][4 * r4] * rl, o[db][4 * r4 + 1] * rl); w.y = cvtpk(o[db][4 * r4 + 2] * rl, o[db][4 * r4 + 3] * rl);
      *reinterpret_cast<v2u*>(Ow + 32 * db + 8 * r4) = w; }
#else
  unsigned char* Ow = O8b + (long)((tid2 >> 6) * QBLK + (tid2 & 31)) * LDO + 4 * ((tid2 >> 5) & 1);
  const float rl4 = rl * 4.0f;
#pragma unroll
  for (int db = 0; db < 4; ++db)
#pragma unroll
    for (int r4 = 0; r4 < 4; ++r4)
      *reinterpret_cast<unsigned*>(Ow + 32 * db + 8 * r4) = pk4_fp8(__builtin_amdgcn_fmed3f(o[db][4 * r4] * rl4, -448.f, 448.f), __builtin_amdgcn_fmed3f(o[db][4 * r4 + 1] * rl4, -448.f, 448.f),
                                                                  __builtin_amdgcn_fmed3f(o[db][4 * r4 + 2] * rl4, -448.f, 448.f), __builtin_amdgcn_fmed3f(o[db][4 * r4 + 3] * rl4, -448.f, 448.f));
  (void)Ob;
#endif
  __syncthreads();
#undef SLOAD
#undef SWRITE
#undef KSLOT
#undef VSLOT
#undef RESC
}
#undef ATT_STEP
#undef MFS
#undef PKC
#undef ANCH
#undef MF8
#undef KSWZ
}
namespace ret {
constexpr int C = 128;
constexpr int KP = 1088, KTILE = 16 * KP, VP = 2112;
constexpr int VIMG = 8 * VP;
constexpr int KT_OFF = 0, V_OFF = 4 * KTILE, ST_OFF = V_OFF + 2 * VIMG, P_OFF = ST_OFF + 2 * KTILE, RET_LDS = P_OFF + 10 * 2048;
DI int crow(int r, int hi) { return (r & 3) + 8 * (r >> 2) + 4 * hi; }
typedef short v4i16_t __attribute__((ext_vector_type(4)));
DI s16x4 vtr(unsigned addr) { return __builtin_bit_cast(s16x4, __builtin_amdgcn_ds_read_tr16_b64_v4i16((LAS v4i16_t*)addr)); }
DI bf16x8 cat8(s16x4 l, s16x4 h) { return (bf16x8){l[0], l[1], l[2], l[3], h[0], h[1], h[2], h[3]}; }
DI bf16x8 ldsr(unsigned addr) { return *(const LAS bf16x8*)(uintptr_t)addr; }
#define RPK4(P, BASE, OUT) do { unsigned a0 = cvt_pk_bf16(P[BASE + 0], P[BASE + 1]), a1 = cvt_pk_bf16(P[BASE + 2], P[BASE + 3]);   \
    unsigned b0 = cvt_pk_bf16(P[BASE + 4], P[BASE + 5]), b1 = cvt_pk_bf16(P[BASE + 6], P[BASE + 7]);                              \
    auto r0 = __builtin_amdgcn_permlane32_swap(a0, b0, false, false); auto r1 = __builtin_amdgcn_permlane32_swap(a1, b1, false, false); \
    v4u w = {r0[0], r1[0], r0[1], r1[1]}; OUT = *reinterpret_cast<bf16x8*>(&w); } while (0)
#define RMFMA(a, b, c) __builtin_amdgcn_mfma_f32_32x32x16_bf16((a), (b), (c), 0, 0, 0)
#define RPRIO(x) __builtin_amdgcn_s_setprio(x)
#define RBAR() do { asm volatile("s_waitcnt lgkmcnt(0)" ::: "memory"); __builtin_amdgcn_s_barrier(); asm volatile("" ::: "memory"); } while (0)

DI void ret_unit(LAS unsigned char* lds, const bf16* __restrict__ QR, const bf16* __restrict__ KR, const bf16* __restrict__ VR, bf16* __restrict__ O,
                 const int rowbase, const int h, const int fwd, const int sl, const float lg) {
    const int tid = opaque_tid(), wid = __builtin_amdgcn_readfirstlane(tid >> 6), lane = tid & 63, r = lane & 31, hi = lane >> 5;
    const int eb = wid >> 2, qb = eb ? 7 - wid : wid, dq = wid & 3;
    const unsigned lbase = (unsigned)(uintptr_t)lds;
    const float lg2 = lg * 1.4426950408889634f;
    const float dC = __builtin_amdgcn_exp2f(lg2 * (float)C);
    const int iq = 32 * qb + r;
    const int kb_lo = fwd ? 0 : qb, ntile = fwd ? qb + 1 : 4 - qb, hup = (ntile + 1) >> 1, t0 = eb ? hup : 0, t1 = eb ? ntile : hup;
    const int vk0 = tid >> 3, vk1 = 64 + (tid >> 3), vch = tid & 7;
    const unsigned vdst0 = lbase + V_OFF + vch * VP + vk0 * 16, vdst1 = lbase + V_OFF + vch * VP + vk1 * 16;
    const bf16* vsrc = VR + (size_t)h * 512 + sl * 64 + vch * 8;
    const bf16* ksrc = KR + ((size_t)((wid >> 2) * 4 + h) * 2 + ((wid >> 1) & 1)) * 8192 + ((wid & 1) * 8 * 64 + lane) * 8;
    const int trblk = (lane >> 4) & 1, trq = (lane & 15) >> 2, trp = lane & 3;
    const unsigned rd_row = lbase + (unsigned)(hi * KP + r * 16);
    const unsigned tr_k = lbase + KT_OFF + (unsigned)((2 * trblk + (trp >> 1)) * KP + (8 * hi + trq) * 16 + 8 * (trp & 1));
    const unsigned tr_v = lbase + V_OFF + (unsigned)((2 * trblk + (trp >> 1)) * VP + (8 * hi + trq) * 16 + 8 * (trp & 1)) + 4 * eb * VP;
    const unsigned p_my = lbase + P_OFF + lane * 16;
    const int pq = fwd ? qb : 3 - qb; const int pslot0 = pq * (pq + 1) / 2;
    f32x16 st0 = {}, st1 = {};
    bf16x8 q[16];
    auto chunk_row = [&](int n) -> int {
        if (fwd) return n < 2 ? rowbase + 128 * n : rowbase + 256 + 128 * (n - 2);
        return n < 2 ? rowbase + 128 * (1 - n) : rowbase + 256 + 128 * (65 - n);
    };
#define ISSUE_K(n) do { const bf16* kp = ksrc + (size_t)(chunk_row(n) >> 6) * 65536; _Pragma("unroll") for (int j = 0; j < 8; ++j) \
        __builtin_amdgcn_global_load_lds((const unsigned*)(kp + j * 512), (LAS unsigned*)(lds + KT_OFF + (wid >> 1) * KTILE + ((wid & 1) * 8 + j) * KP), 16, 0, 0); } while (0)
#define LOAD_V(n, a, b) do { const bf16* vp = vsrc + (size_t)chunk_row(n) * 2048; a = *(const v4u*)(vp + (size_t)vk0 * 2048); b = *(const v4u*)(vp + (size_t)vk1 * 2048); } while (0)
#define WRITE_V(a, b, vbo_) do { v4u t0_, t1_; const float vw0 = __builtin_amdgcn_exp2f(lg2 * (float)(fwd ? (C - 1 - vk0) : vk0)), vw1 = __builtin_amdgcn_exp2f(lg2 * (float)(fwd ? (C - 1 - vk1) : vk1));   \
        t0_.x = cvt_pk_bf16(bf_lo(a.x) * vw0, bf_hi(a.x) * vw0); t0_.y = cvt_pk_bf16(bf_lo(a.y) * vw0, bf_hi(a.y) * vw0); t0_.z = cvt_pk_bf16(bf_lo(a.z) * vw0, bf_hi(a.z) * vw0); t0_.w = cvt_pk_bf16(bf_lo(a.w) * vw0, bf_hi(a.w) * vw0); \
        t1_.x = cvt_pk_bf16(bf_lo(b.x) * vw1, bf_hi(b.x) * vw1); t1_.y = cvt_pk_bf16(bf_lo(b.y) * vw1, bf_hi(b.y) * vw1); t1_.z = cvt_pk_bf16(bf_lo(b.z) * vw1, bf_hi(b.z) * vw1); t1_.w = cvt_pk_bf16(bf_lo(b.w) * vw1, bf_hi(b.w) * vw1); \
        *(LAS v4u*)(uintptr_t)(vdst0 + vbo_) = t0_; *(LAS v4u*)(uintptr_t)(vdst1 + vbo_) = t1_; } while (0)
    { unsigned z_; asm volatile("v_mov_b32 %0, 0" : "=v"(z_));
      for (int i = tid; i < 2 * KTILE / 16; i += 512) *(LAS v4u*)(lds + ST_OFF + i * 16) = (v4u){z_, z_, z_, z_}; }
    v4u va, vb;
    ISSUE_K(0);
    LOAD_V(0, va, vb);
    { const bf16* qp = QR + (size_t)(((chunk_row(2) >> 5) + qb) * 4 + h) * 8192 + lane * 8;
#pragma unroll
      for (int s = 0; s < 16; ++s) q[s] = *(const bf16x8*)(qp + s * 512); }
    WRITE_V(va, vb, 0u);
    LOAD_V(1, va, vb);
#pragma unroll 1
    for (int n = 0; n < 66; ++n) {
        if (n >= 3) asm volatile("s_waitcnt vmcnt(32)" ::: "memory"); else asm volatile("s_waitcnt vmcnt(0)" ::: "memory");
        RBAR();
        const unsigned vb_cur = (unsigned)(n & 1) * VIMG, vb_nxt = (unsigned)((n + 1) & 1) * VIMG;
        const bool lat = n >= 2;
        if (n > 0) {
#pragma unroll
            for (int t = 0; t < 2; ++t) { const int db = 2 * dq + t; const unsigned img = lbase + ST_OFF + (db >> 2) * KTILE + 4 * (db & 3) * KP + (32 * eb + r) * 16 + 8 * hi;
#pragma unroll
                for (int g = 0; g < 4; ++g) { v2u w; const f32x16& sref = t ? st1 : st0; w.x = cvt_pk_bf16(sref[4 * g], sref[4 * g + 1]); w.y = cvt_pk_bf16(sref[4 * g + 2], sref[4 * g + 3]);
                    *(LAS v2u*)(uintptr_t)(img + g * KP) = w; } }
        }
#pragma unroll
        for (int g = 0; g < 16; ++g) { st0[g] *= dC; st1[g] *= dC; }
        {
            const unsigned kb0 = tr_k + (dq >> 1) * KTILE + 8 * (dq & 1) * KP;
            s16x4 v0 = vtr(tr_v + vb_cur), v1 = vtr(tr_v + vb_cur + 64), a0 = vtr(kb0), a1 = vtr(kb0 + 64), b0 = vtr(kb0 + 4 * KP), b1 = vtr(kb0 + 4 * KP + 64);
#pragma unroll
            for (int g = 0; g < 8; ++g) {
                const bf16x8 vf = cat8(v0, v1), kt0 = cat8(a0, a1), kt1 = cat8(b0, b1);
                if (g < 7) { const int g1 = g + 1; const unsigned ka = kb0 + (g1 >> 2) * 2 * KTILE + (32 * ((g1 >> 1) & 1) + 16 * (g1 & 1)) * 16, vaq = tr_v + vb_cur + g1 * 256;
                    v0 = vtr(vaq); v1 = vtr(vaq + 64); a0 = vtr(ka); a1 = vtr(ka + 64); b0 = vtr(ka + 4 * KP); b1 = vtr(ka + 4 * KP + 64); }
                RPRIO(1); st0 = RMFMA(kt0, vf, st0); st1 = RMFMA(kt1, vf, st1); RPRIO(0);
            }
        }
        if (lat) {
#pragma unroll 1
            for (int ti = t0; ti < t1; ++ti) {
                const int kb = kb_lo + ti;
                const unsigned kbase = rd_row + KT_OFF + (kb >> 1) * 2 * KTILE + (kb & 1) * 512;
                f32x16 pt = {};
                bf16x8 c0 = ldsr(kbase), c1 = ldsr(kbase + 2 * KP), c2 = ldsr(kbase + 4 * KP), c3 = ldsr(kbase + 6 * KP);
                __builtin_amdgcn_sched_barrier(0);
#pragma unroll
                for (int sg = 0; sg < 4; ++sg) {
                    bf16x8 n0, n1, n2, n3;
                    if (sg < 3) { const unsigned nb = kbase + ((sg + 1) >> 1) * KTILE + ((sg + 1) & 1) * 8 * KP; n0 = ldsr(nb); n1 = ldsr(nb + 2 * KP); n2 = ldsr(nb + 4 * KP); n3 = ldsr(nb + 6 * KP); }
                    __builtin_amdgcn_sched_barrier(0);
                    RPRIO(1); pt = RMFMA(c0, q[4 * sg], pt); pt = RMFMA(c1, q[4 * sg + 1], pt); pt = RMFMA(c2, q[4 * sg + 2], pt); pt = RMFMA(c3, q[4 * sg + 3], pt); RPRIO(0);
                    __builtin_amdgcn_sched_barrier(0);
                    if (sg < 3) { c0 = n0; c1 = n1; c2 = n2; c3 = n3; }
                }
                const float rowscale = __builtin_amdgcn_exp2f(fwd ? lg2 * (float)(iq - (C - 1)) : -lg2 * (float)iq);
                if (kb == qb) {
#pragma unroll
                    for (int g = 0; g < 16; ++g) { const int j = 32 * kb + crow(g, hi); const bool keep = fwd ? (j <= iq) : (j > iq); pt[g] = keep ? pt[g] * rowscale : 0.f; }
                } else {
#pragma unroll
                    for (int g = 0; g < 16; ++g) pt[g] *= rowscale;
                }
                bf16x8 pa0, pa1; RPK4(pt, 0, pa0); RPK4(pt, 8, pa1);
                const unsigned ps = p_my + (pslot0 + (fwd ? kb : 3 - kb)) * 2048;
                *(LAS bf16x8*)(uintptr_t)ps = pa0; *(LAS bf16x8*)(uintptr_t)(ps + 1024) = pa1;
            }
        }
        RBAR();
        if (n + 1 < 66) WRITE_V(va, vb, vb_nxt);
        if (n + 2 < 66) LOAD_V(n + 2, va, vb);
        if (n + 1 < 66) ISSUE_K(n + 1);
        if (lat) {
            f32x16 opv = {};
            {
                unsigned ps = p_my + (pslot0 + (fwd ? kb_lo : 3 - kb_lo)) * 2048, vaq = tr_v + vb_cur + kb_lo * 512;
                bf16x8 pa0 = ldsr(ps), pa1 = ldsr(ps + 1024); s16x4 x0 = vtr(vaq), x1 = vtr(vaq + 64), x2 = vtr(vaq + 256), x3 = vtr(vaq + 320);
#pragma unroll 1
                for (int ti = 0; ti < ntile; ++ti) {
                    const bf16x8 ca0 = pa0, ca1 = pa1, vf0 = cat8(x0, x1), vf1 = cat8(x2, x3);
                    if (ti + 1 < ntile) { ps += fwd ? 2048 : -2048; vaq += 512; pa0 = ldsr(ps); pa1 = ldsr(ps + 1024); x0 = vtr(vaq); x1 = vtr(vaq + 64); x2 = vtr(vaq + 256); x3 = vtr(vaq + 320); }
                    RPRIO(1); opv = RMFMA(ca0, vf0, opv); opv = RMFMA(ca1, vf1, opv); RPRIO(0);
                }
            }
            f32x16 oqs = {};
            const bool more = n + 1 < 66;
            const bf16* qp = QR + (size_t)(((chunk_row(more ? n + 1 : n) >> 5) + qb) * 4 + h) * 8192 + lane * 8;
            const unsigned sbase = rd_row + ST_OFF + eb * 512;
            bf16x8 c0 = ldsr(sbase), c1 = ldsr(sbase + 2 * KP), c2 = ldsr(sbase + 4 * KP), c3 = ldsr(sbase + 6 * KP);
            __builtin_amdgcn_sched_barrier(0);
#pragma unroll
            for (int sg = 0; sg < 4; ++sg) {
                bf16x8 n0, n1, n2, n3;
                if (sg < 3) { const unsigned nb = sbase + ((sg + 1) >> 1) * KTILE + ((sg + 1) & 1) * 8 * KP; n0 = ldsr(nb); n1 = ldsr(nb + 2 * KP); n2 = ldsr(nb + 4 * KP); n3 = ldsr(nb + 6 * KP); }
                __builtin_amdgcn_sched_barrier(0);
                RPRIO(1); oqs = RMFMA(q[4 * sg], c0, oqs); oqs = RMFMA(q[4 * sg + 1], c1, oqs); oqs = RMFMA(q[4 * sg + 2], c2, oqs); oqs = RMFMA(q[4 * sg + 3], c3, oqs); RPRIO(0);
                __builtin_amdgcn_sched_barrier(0);
                if (sg < 3) { c0 = n0; c1 = n1; c2 = n2; c3 = n3; }
            }
#pragma unroll
            for (int s = 0; s < 16; ++s) q[s] = *(const bf16x8*)(qp + s * 512);
            asm volatile("" ::: "memory");
            bf16* op = O + (size_t)(chunk_row(n) + 32 * qb) * 2048 + h * 512 + sl * 64 + eb * 32 + r;
#pragma unroll
            for (int g = 0; g < 16; ++g) { const int i = 32 * qb + crow(g, hi);
                const float a = __builtin_amdgcn_exp2f(lg2 * (float)(fwd ? (i + 1) : (C - i)));
                op[(size_t)crow(g, hi) * 2048] = (bf16)(cvt_pk_bf16(opv[g] + a * oqs[g], 0.f) & 0xffffu); }
        }
    }
    asm volatile("s_waitcnt vmcnt(0)" ::: "memory");
    __syncthreads();
#undef ISSUE_K
#undef RPRIO
#undef LOAD_V
#undef WRITE_V
}
#undef RPK4
#undef RMFMA
#undef RBAR
}

struct Args { const float* in[22]; float* out; unsigned char* ws; };
typedef const __attribute__((address_space(4))) Args CArgs;
DI CArgs* kargs() { CArgs* p = (CArgs*)__builtin_amdgcn_kernarg_segment_ptr(); asm volatile("" : "+s"(p)); return p; }
struct Frame {
    LAS unsigned char* lds;
    volatile LAS unsigned* MISC;
};
DI int frame_vcu() { const int G = (int)gridDim.x, bx = (int)blockIdx.x; return (G % 8 == 0) ? (bx % 8) * (G / 8) + bx / 8 : bx; }
enum InIdx { I_X = 0, I_C, I_CTX, I_CCTX, I_NORM1, I_NORM2, I_WADA, I_BADA, I_WIN, I_DECF, I_DECB, I_QN, I_KN, I_WRO, I_WAO, I_WOUT, I_WR, I_BR, I_W1, I_B1, I_W2, I_B2 };

template <bool FP8> DI void transpose_task(const float* W, int K, int N, void* WTv, int k0, int n0, int drow0, int lane) {
    const int kr = lane >> 4, c4 = lane & 15;
    const float* src = W + (size_t)(k0 + 8 * kr) * N + n0 + 4 * c4;
    bf16* dst = (bf16*)WTv + (size_t)(drow0 + 4 * c4) * K + k0 + 8 * kr; unsigned char* dst8 = (unsigned char*)WTv + (size_t)(drow0 + 4 * c4) * K + k0 + 8 * kr;
#pragma unroll 2
    for (int g = 0; g < 8; ++g) {
        f32x4 v[8];
#pragma unroll
        for (int j = 0; j < 8; ++j) v[j] = *(const GAS f32x4*)(src + (size_t)(32 * g + j) * N);
#pragma unroll
        for (int cc = 0; cc < 4; ++cc) {
            if constexpr (FP8) { v2u o; o.x = pk4_fp8(16.f * v[0][cc], 16.f * v[1][cc], 16.f * v[2][cc], 16.f * v[3][cc]); o.y = pk4_fp8(16.f * v[4][cc], 16.f * v[5][cc], 16.f * v[6][cc], 16.f * v[7][cc]);     *(GAS v2u*)(dst8 + (size_t)cc * K + 32 * g) = o; }
            else { v4u o; o.x = cvt_pk_bf16(v[0][cc], v[1][cc]); o.y = cvt_pk_bf16(v[2][cc], v[3][cc]); o.z = cvt_pk_bf16(v[4][cc], v[5][cc]); o.w = cvt_pk_bf16(v[6][cc], v[7][cc]);
                *(GAS v4u*)(dst + (size_t)cc * K + 32 * g) = o; } }
    }
}
DI int win_dest_row(int n0) {
    if (n0 >= 2048) return n0;
    const int hb = n0 & ~255, c = n0 & 255, blk = c >> 6, within = c & 63;
    const int nb = blk == 1 ? 2 : (blk == 2 ? 1 : blk);
    return hb + nb * 64 + within;
}
DI int w1_dest_row(int n0) { const int up = n0 >= 1024, c = n0 & 1023; return 256 * (c >> 7) + 128 * up + (c & 127); }

DI void p0_prologue(Frame& F, CArgs* ap) {
    const int L_tid = opaque_tid(), L_lane = L_tid & 63, L_wave = __builtin_amdgcn_readfirstlane(L_tid >> 6);
    unsigned char* ws = ap->ws;
    const int gw = frame_vcu() * NWAVES + L_wave, NGW = ((int)gridDim.x) * NWAVES;
    if (blockIdx.x < 96) {
        LAS float* sc = (LAS float*)(F.lds);
        LAS float* red = (LAS float*)(F.lds + 40960);
        const float* cin = ap->in[I_C]; const float* cctx = ap->in[I_CCTX];
        for (int i = L_tid; i < 9 * 1024; i += 512) { const float v = i < 8192 ? cin[i] : cctx[i - 8192]; sc[i] = v * fast_sigmoid(v); }
        __syncthreads();
        const int n = blockIdx.x * 64 + L_lane; const float* wa = ap->in[I_WADA];
        float acc[9];
#pragma unroll
        for (int r = 0; r < 9; ++r) acc[r] = 0.f;
        for (int k = L_wave * 128; k < L_wave * 128 + 128; ++k) { const float w = wa[(size_t)k * 6144 + n];
#pragma unroll
            for (int r = 0; r < 9; ++r) acc[r] += sc[r * 1024 + k] * w; }
#pragma unroll
        for (int r = 0; r < 9; ++r) red[(L_wave * 9 + r) * 64 + L_lane] = acc[r];
        __syncthreads();
        float* mod = (float*)(ws + WS_MOD);
        for (int i = L_tid; i < 9 * 64; i += 512) { const int r = i >> 6, l = i & 63; float s = ap->in[I_BADA][blockIdx.x * 64 + l];
#pragma unroll
            for (int w = 0; w < 8; ++w) s += red[(w * 9 + r) * 64 + l];
            mod[(size_t)r * 6144 + blockIdx.x * 64 + l] = s; }
        __syncthreads();
    }
    if (blockIdx.x == ((int)gridDim.x) - 1) {
        float* cosr = (float*)(ws + WS_COSR); float* sinr = (float*)(ws + WS_SINR); float* cosa = (float*)(ws + WS_COSA); float* sina = (float*)(ws + WS_SINA);
        for (int i = L_tid; i < 128 * 64; i += 512) { const int pos = i >> 6, f = i & 63; const float inv = powf(10000.0f, -(float)f / 64.0f); const float ang = (float)pos * inv; cosr[i] = cosf(ang); sinr[i] = sinf(ang); }
        for (int i = L_tid; i < 128 * 32; i += 512) { const int pos = i >> 5, f = i & 31; const float inv = powf(10000.0f, -(float)f / 32.0f); const float ang = (float)pos * inv; cosa[i] = cosf(ang); sina[i] = sinf(ang); }
    }
    constexpr int T_IN = (INW / 64) * 4, T_RO = 16 * 8, T_AO = 16 * 4, T_OUT = 16 * 4, T_E1 = 32 * 4, T_E2 = 16 * 4;
    constexpr int NTASK = T_IN + T_RO + T_AO + T_OUT + NEXP * T_E1 + NEXP * T_E2;
    for (int it = gw; it < NTASK; it += NGW) {
        int r = it;
        if (r < T_IN) { const int nb = r >> 2, kq = r & 3; transpose_task<true>(ap->in[I_WIN], 1024, INW, (unsigned char*)(ws + WS_WIN), 256 * kq, 64 * nb, win_dest_row(64 * nb), L_lane); continue; } r -= T_IN;
        if (r < T_RO) { const int nb = r >> 3, kq = r & 7; transpose_task<true>(ap->in[I_WRO], 2048, 1024, (unsigned char*)(ws + WS_WRO), 256 * kq, 64 * nb, 64 * nb, L_lane); continue; } r -= T_RO;
        if (r < T_AO) { const int nb = r >> 2, kq = r & 3; transpose_task<true>(ap->in[I_WAO], 1024, 1024, (unsigned char*)(ws + WS_WAO), 256 * kq, 64 * nb, 64 * nb, L_lane); continue; } r -= T_AO;
        if (r < T_OUT) { const int nb = r >> 2, kq = r & 3; transpose_task<true>(ap->in[I_WOUT], 1024, 1024, (unsigned char*)(ws + WS_WOUT), 256 * kq, 64 * nb, 64 * nb, L_lane); continue; } r -= T_OUT;
        if (r < NEXP * T_E1) { const int e = r / T_E1, q = r % T_E1, nb = q >> 2, kq = q & 3;
            transpose_task<true>(ap->in[I_W1] + (size_t)e * 1024 * 2048, 1024, 2048, (unsigned char*)(ws + WS_W1) + (size_t)e * 2048 * 1024, 256 * kq, 64 * nb, w1_dest_row(64 * nb), L_lane); continue; } r -= NEXP * T_E1;
        { const int e = r / T_E2, q = r % T_E2, nb = q >> 2, kq = q & 3;
            transpose_task<true>(ap->in[I_W2] + (size_t)e * 1024 * 1024, 1024, 1024, (unsigned char*)(ws + WS_W2) + (size_t)e * 1024 * 1024, 256 * kq, 64 * nb, 64 * nb, L_lane); }
    }
}

DI void p_modulate(Frame& F, CArgs* ap) {
    const int L_tid = opaque_tid(), L_lane = L_tid & 63, L_wave = __builtin_amdgcn_readfirstlane(L_tid >> 6);
    const unsigned char* ws = ap->ws; const float* mod = (const float*)(ws + WS_MOD); unsigned char* H1 = ap->ws + WS_H1;
    const int gw = frame_vcu() * NWAVES + L_wave, NGW = ((int)gridDim.x) * NWAVES;
    const int per = (MROWS + NGW - 1) / NGW; const int r0 = gw * per, r1 = (r0 + per) < MROWS ? (r0 + per) : MROWS;
    int cur = -1; f32x4 pa[4], pb[4];
    for (int rowb = r0; rowb < r1; rowb += 3) {
        f32x4 v[3][4];
#pragma unroll
        for (int q = 0; q < 3; ++q) { const int row = (rowb + q) < r1 ? (rowb + q) : (r1 - 1); const int b = row / LT, p = row - b * LT;
            const float* src = p < LCTX ? ap->in[I_CTX] + ((size_t)b * LCTX + p) * DM : ap->in[I_X] + ((size_t)b * SEQ + (p - LCTX)) * DM;
#pragma unroll
            for (int j = 0; j < 4; ++j) v[q][j] = *((const GAS f32x4*)src + 64 * j + L_lane); }
#pragma unroll
        for (int q = 0; q < 3; ++q) { const int row = rowb + q; if (row < r1) {
            const int b = row / LT, p = row - b * LT; const int id = p < LCTX ? 8 : b;
            if (id != cur) { cur = id;
#pragma unroll
                for (int j = 0; j < 4; ++j) { const int k = 256 * j + 4 * L_lane; const f32x4 g = *(const f32x4*)(ap->in[I_NORM1] + k), sh = *(const f32x4*)(mod + (size_t)id * 6144 + k), sc = *(const f32x4*)(mod + (size_t)id * 6144 + 1024 + k);
                    pa[j] = g * (sc + 1.0f); pb[j] = sh; } }
            float s = 0.f;
#pragma unroll
            for (int j = 0; j < 4; ++j) s += (v[q][j].x * v[q][j].x + v[q][j].y * v[q][j].y) + (v[q][j].z * v[q][j].z + v[q][j].w * v[q][j].w);
            const float rstd = 1.0f / sqrtf(wave_sum(s) * (1.0f / DM) + EPS);
            GAS unsigned* o = (GAS unsigned*)(H1 + (size_t)row * DM) + L_lane;
#pragma unroll
            for (int j = 0; j < 4; ++j) { const f32x4 y = (v[q][j] * rstd * pa[j] + pb[j]) * 4.0f;
                o[64 * j] = pk4_fp8(__builtin_amdgcn_fmed3f(y.x, -448.f, 448.f), __builtin_amdgcn_fmed3f(y.y, -448.f, 448.f), __builtin_amdgcn_fmed3f(y.z, -448.f, 448.f), __builtin_amdgcn_fmed3f(y.w, -448.f, 448.f)); } } }
    }
}

DI void p_ar(Frame& F, CArgs* ap) {
    const int L_tid = opaque_tid(), L_lane = L_tid & 63, L_wave = __builtin_amdgcn_readfirstlane(L_tid >> 6);
    unsigned char* ws = ap->ws; const int gw = frame_vcu() * NWAVES + L_wave, NGW = ((int)gridDim.x) * NWAVES;
    bf16* GR = (bf16*)(ws + WS_GR); const bf16* OF = (const bf16*)(ws + WS_OF); const bf16* OB = (const bf16*)(ws + WS_OB);
    for (int i = gw; i < NBH * SEQ; i += NGW) {
        const int row = (i >> 13) * LT + LCTX + (i & 8191);
        v4u qa[4], qb[4], qg[4];
#pragma unroll
        for (int hh = 0; hh < 4; ++hh) { const size_t off = (size_t)row * 2048 + hh * 512 + 8 * L_lane; qa[hh] = *(const v4u*)(OF + off); qb[hh] = *(const v4u*)(OB + off); qg[hh] = *(const v4u*)(GR + off); }
#pragma unroll
        for (int hh = 0; hh < 4; ++hh) {
            f32x4 a0, a1, b0, b1, g0, g1; pg8::unpack8(qa[hh], a0, a1); pg8::unpack8(qb[hh], b0, b1); pg8::unpack8(qg[hh], g0, g1);
            a0 += b0; a1 += b1;
            float s = (a0.x * a0.x + a0.y * a0.y) + (a0.z * a0.z + a0.w * a0.w) + (a1.x * a1.x + a1.y * a1.y) + (a1.z * a1.z + a1.w * a1.w);
            const float rstd = 4.0f / sqrtf(wave_sum(s) * (1.0f / 512.0f) + EPS);
            const f32x4 y0 = a0 * g0 * rstd, y1 = a1 * g1 * rstd; v2u w;
#define AQ(v) __builtin_amdgcn_fmed3f((v), -448.f, 448.f)
            w.x = pk4_fp8(AQ(y0.x), AQ(y0.y), AQ(y0.z), AQ(y0.w)); w.y = pk4_fp8(AQ(y1.x), AQ(y1.y), AQ(y1.z), AQ(y1.w));
#undef AQ
            *(v2u*)((unsigned char*)GR + (size_t)row * 4096 + hh * 512 + 8 * L_lane) = w;
        }
    }
}
DI void p_knorm(Frame& F, CArgs* ap) {
    const int L_tid = opaque_tid(), L_lane = L_tid & 63, L_wave = __builtin_amdgcn_readfirstlane(L_tid >> 6);
    unsigned char* ws = ap->ws; const int gw = frame_vcu() * NWAVES + L_wave, NGW = ((int)gridDim.x) * NWAVES;
    const bf16* KA = (const bf16*)(ws + WS_KA); unsigned char* KA8 = ws + WS_KA8; const float* kn = ap->in[I_KN]; const float* cosa = (const float*)(ws + WS_COSA); const float* sina = (const float*)(ws + WS_SINA);
    const int d = (4 * L_lane) & 127;
    const f32x4 gk = *(const f32x4*)(kn + d);
    for (int row = gw; row < MH; row += NGW) {
        const int p = row % LT; const GAS v2u* ptr = (const GAS v2u*)(KA + (size_t)row * 256) + L_lane;
        const v2u w = *ptr; f32x4 v = {bf_lo(w.x), bf_hi(w.x), bf_lo(w.y), bf_hi(w.y)};
        float s = (v.x * v.x + v.y * v.y) + (v.z * v.z + v.w * v.w);
        s += lane_xor<1>(s); s += lane_xor<2>(s); s += lane_xor<4>(s); s += lane_xor<8>(s); s += lane_xor<16>(s);
        v = v * (1.0f / sqrtf(s * (1.0f / 128.0f) + EPS)) * gk;
        if (p >= LCTX) {
            const int t = p - LCTX, axis = (d >> 6) & 1, half = (d >> 5) & 1, f = d & 31, pos = axis ? (t & 63) : (t >> 6);
            const f32x4 cs = *(const f32x4*)(cosa + pos * 32 + f), sn = *(const f32x4*)(sina + pos * 32 + f);
            f32x4 o; o.x = lane_xor<8>(v.x); o.y = lane_xor<8>(v.y); o.z = lane_xor<8>(v.z); o.w = lane_xor<8>(v.w);
            v = half ? (v * cs + o * sn) : (v * cs - o * sn);
        }
        *(unsigned*)(KA8 + ((size_t)(L_lane >> 5) * MH + row) * 128 + (((((L_lane & 31) >> 2) ^ ((row >> 1) & 7)) << 4) | (4 * (L_lane & 3)))) =
            pk4_fp8(__builtin_amdgcn_fmed3f(v.x, -448.f, 448.f), __builtin_amdgcn_fmed3f(v.y, -448.f, 448.f), __builtin_amdgcn_fmed3f(v.z, -448.f, 448.f), __builtin_amdgcn_fmed3f(v.w, -448.f, 448.f));
    }
}

DI void p_vprep(Frame& F, CArgs* ap) {
    const int L_tid = opaque_tid(), L_lane = L_tid & 63, L_wave = __builtin_amdgcn_readfirstlane(L_tid >> 6);
    unsigned char* ws = ap->ws; const int gw = frame_vcu() * NWAVES + L_wave, NGW = ((int)gridDim.x) * NWAVES;
    for (int it = gw; it < (MH / 64) * 2; it += NGW) {
        const int tile = it >> 1, kvh = it & 1;
        const bf16* src = (const bf16*)(ws + WS_VA) + (size_t)tile * 64 * 256 + kvh * 128 + 2 * L_lane;
        unsigned char* dst = ws + WS_VA8 + ((size_t)kvh * (MH / 64) + tile) * 8192 + 128 * L_lane;
        const int x = (L_lane >> 1) & 3;
#pragma unroll
        for (int c = 0; c < 4; ++c) {
            v4u lo, hi_;
#pragma unroll
            for (int e = 0; e < 4; ++e) { const int q = 4 * c + e, k0 = 32 * ((q >> 2) & 1) + 8 * (q & 3) + 4 * (q >> 3);
                const unsigned w0 = *(const unsigned*)(src + (k0 + 0) * 256), w1 = *(const unsigned*)(src + (k0 + 1) * 256), w2 = *(const unsigned*)(src + (k0 + 2) * 256), w3 = *(const unsigned*)(src + (k0 + 3) * 256);
#define VQ(v) __builtin_amdgcn_fmed3f((v) * 8.0f, -448.f, 448.f)
                lo[e] = pk4_fp8(VQ(bf_lo(w0)), VQ(bf_lo(w1)), VQ(bf_lo(w2)), VQ(bf_lo(w3))); hi_[e] = pk4_fp8(VQ(bf_hi(w0)), VQ(bf_hi(w1)), VQ(bf_hi(w2)), VQ(bf_hi(w3)));
#undef VQ
            }
            *(v4u*)(dst + ((c ^ x) << 4)) = lo; *(v4u*)(dst + 64 + ((c ^ x) << 4)) = hi_;
        }
    }
}
DI void p_router(Frame& F, CArgs* ap) {
    const int L_tid = opaque_tid(), L_lane = L_tid & 63, L_wave = __builtin_amdgcn_readfirstlane(L_tid >> 6);
    unsigned char* ws = ap->ws; const int gw = frame_vcu() * NWAVES + L_wave, NGW = ((int)gridDim.x) * NWAVES;
    LAS float* wrs = (LAS float*)F.lds;
    LAS float* xs = (LAS float*)(F.lds + 16384) + L_wave * (32 * 129);
    const float* mod = (const float*)(ws + WS_MOD); const float* x1 = ap->out; unsigned char* H2 = (unsigned char*)(ws + WS_H2);
    int* tope = (int*)(ws + WS_TOPE); float* topw = (float*)(ws + WS_TOPW); int* wcnt = (int*)(ws + WS_WCNT);
    const int e_l = L_lane & 31, hi = L_lane >> 5; const float bias = ap->in[I_BR][e_l];
    const int nit = (TTOK / 32 + NGW - 1) / NGW;
    for (int it = 0; it < nit; ++it) {
        const int ch = gw + it * NGW; const bool active = ch < TTOK / 32; const int chc = active ? ch : 0;
        const int b = (chc * 32) / SEQ; float rs = 0.f;
        {
            f32x4 pa[4], pb[4];
#pragma unroll
            for (int j = 0; j < 4; ++j) { const int k = 256 * j + 4 * L_lane; const f32x4 g = *(const f32x4*)(ap->in[I_NORM2] + k), sh = *(const f32x4*)(mod + (size_t)b * 6144 + 3072 + k), sc = *(const f32x4*)(mod + (size_t)b * 6144 + 4096 + k);
                pa[j] = g * (sc + 1.0f); pb[j] = sh; }
            if (active) for (int tb = 0; tb < 32; tb += 4) {
                f32x4 v[4][4];
#pragma unroll
                for (int q = 0; q < 4; ++q) { const float* src = x1 + (size_t)(ch * 32 + tb + q) * DM;
#pragma unroll
                    for (int j = 0; j < 4; ++j) { v[q][j] = *((const GAS f32x4*)src + 64 * j + L_lane);
                    } }
#pragma unroll
                for (int q = 0; q < 4; ++q) { const int tt = tb + q, t = ch * 32 + tt; float s = 0.f;
#pragma unroll
                    for (int j = 0; j < 4; ++j) s += (v[q][j].x * v[q][j].x + v[q][j].y * v[q][j].y) + (v[q][j].z * v[q][j].z + v[q][j].w * v[q][j].w);
                    const float rstd = 1.0f / sqrtf(wave_sum(s) * (1.0f / DM) + EPS);
                    rs = (e_l == tt) ? rstd : rs;
                    GAS unsigned* o = (GAS unsigned*)(H2 + (size_t)t * DM) + L_lane;
#pragma unroll
                    for (int j = 0; j < 4; ++j) { const f32x4 y = v[q][j] * rstd * pa[j] + pb[j]; o[64 * j] = pk4_fp8(4.f * y.x, 4.f * y.y, 4.f * y.z, 4.f * y.w); } }
            }
        }
        f32x16 acc = {};
        f32x4 xr[16];
#pragma unroll
        for (int i2 = 0; i2 < 16; ++i2) xr[i2] = *(const GAS f32x4*)(x1 + (size_t)(chc * 32 + 2 * i2 + hi) * DM + 4 * e_l);
        for (int sl = 0; sl < 8; ++sl) {
            __syncthreads();
            { const f32x4* wsrc = (const f32x4*)(ap->in[I_WR] + (size_t)sl * 128 * 32); for (int i = L_tid; i < 1024; i += 512) *(LAS f32x4*)(wrs + 4 * i) = wsrc[i]; }
            const int k4 = sl * 128 + 4 * e_l; const f32x4 g = *(const f32x4*)(ap->in[I_NORM2] + k4), sh = *(const f32x4*)(mod + (size_t)b * 6144 + 3072 + k4), sc = *(const f32x4*)(mod + (size_t)b * 6144 + 4096 + k4);
            const f32x4 pa = g * (sc + 1.0f);
#pragma unroll
            for (int i2 = 0; i2 < 16; ++i2) { const int tok = 2 * i2 + hi; const float r = __shfl(rs, tok);
                const f32x4 y = xr[i2] * r * pa + sh;
                LAS float* d = xs + tok * 129 + 4 * e_l; d[0] = y.x; d[1] = y.y; d[2] = y.z; d[3] = y.w; }
            { const int kn = (sl < 7 ? sl + 1 : 7) * 128 + 4 * e_l;
#pragma unroll
                for (int i2 = 0; i2 < 16; ++i2) xr[i2] = *(const GAS f32x4*)(x1 + (size_t)(chc * 32 + 2 * i2 + hi) * DM + kn); }
            __syncthreads();
#pragma unroll 8
            for (int s = 0; s < 64; ++s) acc = __builtin_amdgcn_mfma_f32_32x32x2f32(xs[e_l * 129 + 2 * s + hi], wrs[(2 * s + hi) * 32 + e_l], acc, 0, 0, 0);
        }
        int cnt = 0;
#pragma unroll
        for (int g = 0; g < 16; ++g) {
            const int tok = (g & 3) + 8 * (g >> 2) + 4 * hi; float lv = acc[g] + bias; int se[4]; float sv[4];
#pragma unroll
            for (int k = 0; k < 4; ++k) { float bv = lv; int be = e_l;
#pragma unroll
                for (int o = 1; o < 32; o <<= 1) { const float ov = __shfl_xor(bv, o); const int oe = __shfl_xor(be, o); if (ov > bv || (ov == bv && oe < be)) { bv = ov; be = oe; } }
                se[k] = be; sv[k] = bv; if (e_l == be) { lv = -3.0e38f; ++cnt; } }
            const float e1 = __expf(sv[1] - sv[0]), e2 = __expf(sv[2] - sv[0]), e3 = __expf(sv[3] - sv[0]); const float inv = 1.0f / (1.0f + e1 + e2 + e3);
            if (active && e_l == 0) { const int t = ch * 32 + tok; *(int4*)(tope + (size_t)t * 4) = make_int4(se[0], se[1], se[2], se[3]); *(float4*)(topw + (size_t)t * 4) = make_float4(inv, e1 * inv, e2 * inv, e3 * inv); }
        }
        cnt += __shfl_xor(cnt, 32);
        if (active && L_lane < 32) wcnt[ch * 32 + L_lane] = cnt;
    }
}

DI void p_sort(Frame& F, CArgs* ap, const int th) {
    const int L_tid = opaque_tid(), L_lane = L_tid & 63, L_wave = __builtin_amdgcn_readfirstlane(L_tid >> 6);
    unsigned char* ws = ap->ws; const int gw = frame_vcu() * NWAVES + L_wave, NGW = ((int)gridDim.x) * NWAVES;
    LAS int* cnt = (LAS int*)F.lds;
    LAS int* segsum = (LAS int*)(F.lds + MISC_OFF + 256);
    LAS int* tot = segsum + 512;
    LAS int* tileb = tot + 32;
    const int* wc = (const int*)(ws + WS_WCNT) + (size_t)th * 1024 * 32;
    for (int i = L_tid; i < 1024 * 32 / 4; i += 512) *(LAS v4u*)(cnt + 4 * i) = *(const v4u*)(wc + 4 * i);
    __syncthreads();
    { const int e = L_tid & 31, seg = L_tid >> 5; int s = 0; for (int w = 0; w < 64; ++w) s += cnt[(seg * 64 + w) * 32 + e]; segsum[seg * 32 + e] = s; }
    __syncthreads();
    if (L_tid < 32) { int s = 0; for (int g = 0; g < 16; ++g) s += segsum[g * 32 + L_tid]; tot[L_tid] = s; }
    __syncthreads();
    if (L_tid == 0) { int a = 0; for (int e = 0; e < 32; ++e) { tileb[e] = a; a += (tot[e] + 255) >> 8; } tileb[32] = a; }
    __syncthreads();
    int* rowtok = (int*)(ws + WS_ROWTOK); int* rowdst = (int*)(ws + WS_ROWDST) + (size_t)th * TH_TOK * 4; float* roww = (float*)(ws + WS_ROWW);
    const int vcu_ = frame_vcu(), G_ = (int)gridDim.x;
    if (vcu_ == G_ - 1) { int* tb = (int*)(ws + WS_TILEB); if (L_tid < 33) tb[L_tid] = tileb[L_tid];
        for (int t = L_tid; t < tileb[32]; t += 512) { int e = 0; for (int q = 1; q < 32; ++q) if (t >= tileb[q]) e = q; tb[64 + t] = e; } }
    if (vcu_ >= G_ - 33 && vcu_ < G_ - 1) { const int e = vcu_ - (G_ - 33); const int r0 = tileb[e] * 256 + tot[e], r1 = tileb[e + 1] * 256;
        for (int r = r0 + L_tid; r < r1; r += 512) { rowtok[r] = th * TH_TOK; roww[r] = 0.f; } }
    const int* tope = (const int*)(ws + WS_TOPE); const float* topw = (const float*)(ws + WS_TOPW);
    for (int wcl = gw; wcl < 1024; wcl += NGW) {
        int run = 0;
        { const int e = L_lane & 31, h = L_lane >> 5, seg = wcl >> 6; int a = 0;
#pragma unroll 4
            for (int g = h; g < seg; g += 2) a += segsum[g * 32 + e];
#pragma unroll 4
            for (int w = seg * 64 + h; w < wcl; w += 2) a += cnt[w * 32 + e];
            const auto sw_ = __builtin_amdgcn_permlane32_swap((unsigned)a, (unsigned)a, false, false);
            run = tileb[e] * 256 + (int)(sw_[0] + sw_[1]); }
#pragma unroll 1
        for (int tt = 0; tt < 32; ++tt) {
            const int t = th * TH_TOK + wcl * 32 + tt; const int4 es = *(const int4*)(tope + (size_t)t * 4); const float4 wsv = *(const float4*)(topw + (size_t)t * 4);
            const int ee[4] = {es.x, es.y, es.z, es.w}; const float wv[4] = {wsv.x, wsv.y, wsv.z, wsv.w};
#pragma unroll
            for (int s = 0; s < 4; ++s) { const int pos = __shfl(run, ee[s]); if (L_lane == ee[s]) ++run;
                if (L_lane == 0) { rowtok[pos] = t; rowdst[(wcl * 32 + tt) * 4 + s] = pos; roww[pos] = wv[s]; } }
        }
    }
}

DI void p_combine(Frame& F, CArgs* ap, const int th) {
    const int L_tid = opaque_tid(), L_lane = L_tid & 63, L_wave = __builtin_amdgcn_readfirstlane(L_tid >> 6);
    unsigned char* ws = ap->ws; const int gw = frame_vcu() * NWAVES + L_wave, NGW = ((int)gridDim.x) * NWAVES;
    const float* mod = (const float*)(ws + WS_MOD); const bf16* Y2 = (const bf16*)(ws + WS_Y2); const int* tokpos = (const int*)(ws + WS_ROWDST) + (size_t)th * TH_TOK * 4;
    for (int tl = gw; tl < TH_TOK; tl += NGW) {
        const int t = th * TH_TOK + tl, b = t / SEQ; const int4 pp = *(const int4*)(tokpos + (size_t)tl * 4); const int prow[4] = {pp.x, pp.y, pp.z, pp.w};
#pragma unroll
        for (int jj = 0; jj < 2; ++jj) { const int c0 = 512 * jj + 8 * L_lane;
            f32x4 a0 = {0.f, 0.f, 0.f, 0.f}, a1 = {0.f, 0.f, 0.f, 0.f};
#pragma unroll
            for (int s = 0; s < 4; ++s) { f32x4 y0, y1; pg8::unpack8(*(const v4u*)(Y2 + (size_t)prow[s] * 1024 + c0), y0, y1); a0 += y0; a1 += y1; }
            const f32x4 g0 = *(const f32x4*)(mod + (size_t)b * 6144 + 5120 + c0), g1 = *(const f32x4*)(mod + (size_t)b * 6144 + 5120 + c0 + 4);
            float* op = ap->out + (size_t)t * DM + c0;
            const f32x4 x0 = *(const f32x4*)op, x1v = *(const f32x4*)(op + 4);
            *(f32x4*)op = x0 + g0 * a0; *(f32x4*)(op + 4) = x1v + g1 * a1; }
    }
}

#ifdef DIAG_ATT
#ifndef DIAG_BL
#define DIAG_BL 0
#endif
#ifndef DIAG_HALF
#define DIAG_HALF 0
#endif
constexpr size_t WS_DIAG = 1015 * MiB;
constexpr size_t WS_DIAG_Q = WS_DIAG + 5 * MiB, WS_DIAG_S = WS_DIAG + 6 * MiB, WS_DIAG_R = WS_DIAG + 7 * MiB;
__device__ const int diag_h[8] = {0, 1, 2, 3, 4, 5, 6, 7};
__device__ const int diag_t[8] = {0, 63, 64, 1000, 4095, 4873, 8000, 8191};
DI void diag_pre_k(Frame& F, CArgs* ap) {
    unsigned char* ws = ap->ws; const int tid = opaque_tid();
    const v4u* src = (const v4u*)(ws + WS_KA) + (size_t)DIAG_BL * LT * 256 / 8; v4u* dst = (v4u*)(ws + WS_DIAG);
    for (int i = blockIdx.x * 512 + tid; i < LT * 256 / 8; i += ((int)gridDim.x) * 512) dst[i] = src[i];
}
DI void diag_pre_q(Frame& F, CArgs* ap) {
    unsigned char* ws = ap->ws; const int tid = opaque_tid();
    if (blockIdx.x == 0) { const bf16* QA = (const bf16*)(ws + WS_QA); bf16* dq = (bf16*)(ws + WS_DIAG_Q);
        for (int i = tid; i < 8 * 128; i += 512) { const int s = i >> 7, d = i & 127; dq[i] = QA[(size_t)(DIAG_BL * LT + LCTX + diag_t[s]) * 1024 + diag_h[s] * 128 + d]; } }
}
DI void diag_normrope(float* x  , const float* gain, int t, bool rope, int lane) {
    float a = x[lane], b = x[lane + 64]; float ss = wave_sum(a * a + b * b); const float rstd = 1.0f / sqrtf(ss / 128.0f + EPS);
    a *= rstd * gain[lane]; b *= rstd * gain[lane + 64]; x[lane] = a; x[lane + 64] = b;
    asm volatile("s_waitcnt lgkmcnt(0)" ::: "memory");
    if (rope) {
        float o[2];
        for (int q = 0; q < 2; ++q) { const int d = lane + 64 * q, axis = d >> 6, half = (d >> 5) & 1, f = d & 31; const float pos = axis ? (float)(t & 63) : (float)(t >> 6);
            const float ang = pos * powf(10000.0f, -(float)f / 32.0f); const float cs = cosf(ang), sn = sinf(ang); const float me = x[d], other = x[d ^ 32];
            o[q] = half ? (me * cs + other * sn) : (me * cs - other * sn); }
        asm volatile("s_waitcnt lgkmcnt(0)" ::: "memory");
        x[lane] = o[0]; x[lane + 64] = o[1];
        asm volatile("s_waitcnt lgkmcnt(0)" ::: "memory");
    }
}
DI void diag_post(Frame& F, CArgs* ap, LAS unsigned char* lds) {
    if (blockIdx.x != 0) return;
    unsigned char* ws = ap->ws; const int tid = opaque_tid(), lane = tid & 63, w = tid >> 6;
    float* xq = (float*)(lds) + w * 256; float* xk = xq + 128;
    const bf16* dq = (const bf16*)(ws + WS_DIAG_Q); const bf16* K = (const bf16*)(ws + WS_DIAG); const bf16* V = (const bf16*)(ws + WS_VA) + (size_t)DIAG_BL * LT * 256; float* S = (float*)(ws + WS_DIAG_S) + (size_t)w * LT;
    const int h = diag_h[w], t = diag_t[w], kvh = h >> 2;
    xq[lane] = __uint_as_float((unsigned)dq[w * 128 + lane] << 16); xq[lane + 64] = __uint_as_float((unsigned)dq[w * 128 + lane + 64] << 16);
    asm volatile("s_waitcnt lgkmcnt(0)" ::: "memory");
    diag_normrope(xq, ap->in[I_QN], t, true, lane);
    float mx = -1e30f;
    for (int j = 0; j < LT; ++j) {
        xk[lane] = __uint_as_float((unsigned)K[(size_t)j * 256 + kvh * 128 + lane] << 16); xk[lane + 64] = __uint_as_float((unsigned)K[(size_t)j * 256 + kvh * 128 + lane + 64] << 16);
        asm volatile("s_waitcnt lgkmcnt(0)" ::: "memory");
        diag_normrope(xk, ap->in[I_KN], j - LCTX, j >= LCTX, lane);
        const float sc = wave_sum(xq[lane] * xk[lane] + xq[lane + 64] * xk[lane + 64]) * 0.088388347648318440f;
        if (lane == 0) S[j] = sc; mx = fmaxf(mx, sc);
    }
    asm volatile("s_waitcnt vmcnt(0)" ::: "memory");
    float l = 0.f, o0 = 0.f, o1 = 0.f;
    for (int j = 0; j < LT; ++j) { const float p = __expf(__hip_atomic_load(S + j, __ATOMIC_RELAXED, __HIP_MEMORY_SCOPE_AGENT) - mx); l += p;
        o0 += p * __uint_as_float((unsigned)V[(size_t)j * 256 + kvh * 128 + lane] << 16); o1 += p * __uint_as_float((unsigned)V[(size_t)j * 256 + kvh * 128 + lane + 64] << 16); }
    o0 /= l; o1 /= l;
    const bf16* O = (const bf16*)(ws + WS_QA) + (size_t)(DIAG_BL * LT + LCTX + t) * 1024 + h * 128;
    const float f0 = __uint_as_float((unsigned)O[lane] << 16), f1 = __uint_as_float((unsigned)O[lane + 64] << 16);
    float err = fmaxf(fabsf(f0 - o0), fabsf(f1 - o1)), mag = fmaxf(fabsf(o0), fabsf(o1));
#define WMAX(x) do { x = fmaxf(x, lane_xor<1>(x)); x = fmaxf(x, lane_xor<2>(x)); x = fmaxf(x, lane_xor<4>(x)); x = fmaxf(x, lane_xor<8>(x)); x = fmaxf(x, lane_xor<16>(x)); \
      auto rr = __builtin_amdgcn_permlane32_swap(__float_as_uint(x), __float_as_uint(x), false, false); x = fmaxf(__uint_as_float(rr[0]), __uint_as_float(rr[1])); } while (0)
    WMAX(err); WMAX(mag);
#undef WMAX
    float* red = (float*)(lds + 16384);
    if (lane == 0) red[w] = err / mag;
    __syncthreads();
    if (tid == 0) { float m = 0.f; for (int q = 0; q < 8; ++q) m = fmaxf(m, red[q]); *(float*)(ws + WS_DIAG_R) = m; }
}
#endif
#ifndef REP_P0
#define REP_P0 1
#endif
#ifndef REP_ROUTER
#define REP_ROUTER 1
#endif
#ifndef REP_GA
#define REP_GA 1
#endif
#ifndef REP_GC
#define REP_GC 1
#endif
#ifndef REP_GM
#define REP_GM 1
#endif
#ifndef REP_GM4
#define REP_GM4 REP_GM
#endif
#ifndef REP_RET
#define REP_RET 1
#endif
#ifndef REP_PASS
#define REP_PASS 1
#endif
__global__ void __launch_bounds__(NWAVES * 64, 2) mk_fwd(Args args) {
    extern __shared__ __attribute__((aligned(16))) unsigned char lds[];
    Frame F;
    F.lds = (LAS unsigned char*)lds;
    F.MISC = (volatile LAS unsigned*)(F.lds + MISC_OFF);
    for (int u = threadIdx.x; u < (LDS_BYTES - LDSCTL_OFF) / 4; u += NWAVES * 64) ((LAS unsigned*)(F.lds + LDSCTL_OFF))[u] = 0u;
    __syncthreads();
    if ((threadIdx.x & 63) == 0) ((LAS int*)(F.lds + LDSCTL_OFF))[hw_wave_key()] = (int)(threadIdx.x >> 6);
    __syncthreads();
    (void)xcd_barrier_post((unsigned*)((gu32*)(kargs()->ws + WS_CTL) + CW_BAR), F.MISC + 8);
#define GRID_BAR() do { XcdBarrier bb_; bb_.bar = (unsigned*)((gu32*)(kargs()->ws + WS_CTL) + CW_BAR); bb_.x = (unsigned)__builtin_amdgcn_readfirstlane((int)xb_xcc_id()); \
        bb_.st = (volatile LAS unsigned*)(uintptr_t)(MISC_OFF + 32); xcd_barrier(bb_); } while (0)
#ifndef SKIP_P0
    for (int rep_ = 0; rep_ < REP_P0; ++rep_) { p0_prologue(F, kargs()); __syncthreads(); }
#endif
    GRID_BAR();
#ifndef SKIP_MODU
    for (int rep_ = 0; rep_ < REP_PASS; ++rep_) { p_modulate(F, kargs()); __syncthreads(); }
#endif
    GRID_BAR();

#pragma unroll 1
    for (int half = 0; half < 2; ++half) {
#define H1h ((const unsigned char*)(ws + WS_H1) + (size_t)half * MH * DM)
#define Yh ((bf16*)(ws + WS_Y))
#define Y8h ((unsigned char*)(ws + WS_H1) + (size_t)half * MH * DM)
#ifndef SKIP_A1
        for (int rep_ = 0; rep_ < REP_GA; ++rep_) { CArgs* ap = kargs(); unsigned char* ws = ap->ws;
            pg8::SchedA1 S{((int)gridDim.x), (int)blockIdx.x, 1};
            pg8::EpiA1 E{(bf16*)(ws + WS_QR), (bf16*)(ws + WS_KR), (bf16*)(ws + WS_VR), (bf16*)(ws + WS_KA), (bf16*)(ws + WS_VA), (const float*)(ws + WS_COSR), (const float*)(ws + WS_SINR)};
            pg8::gemm_phase<pg8::EpiA1, pg8::SchedA1, false, true>(F.lds + RING_OFF, H1h, ws + WS_WIN, DM, DM, DM, S, E, nullptr);
        }
#endif
        GRID_BAR();
#ifndef SKIP_RET
        for (int rep_ = 0; rep_ < REP_RET; ++rep_)
        for (int u = frame_vcu(); u < 256; u += ((int)gridDim.x)) { CArgs* ap = kargs(); unsigned char* ws = ap->ws;
            const int bh = u >> 4, bl = bh >> 2, h = bh & 3, dir = (u >> 3) & 1, sl = u & 7;
            const float raw = ap->in[dir ? I_DECB : I_DECF][h];
            const float lg = -log1pf(expf(raw));
            ret::ret_unit(F.lds + RING_OFF, (const bf16*)(ws + WS_QR), (const bf16*)(ws + WS_KR), (const bf16*)(ws + WS_VR), (bf16*)(ws + (dir ? WS_OB : WS_OF)), bl * LT, h, dir == 0, sl, lg);
        }
#endif
        GRID_BAR();
#ifdef DIAG_ATT
        if (half == DIAG_HALF) diag_pre_k(F, kargs());
        GRID_BAR();
#endif
#ifndef SKIP_B2
        p_knorm(F, kargs()); p_vprep(F, kargs());
#endif
#ifndef SKIP_B1
        for (int rep_ = 0; rep_ < REP_GA; ++rep_) { CArgs* ap = kargs(); unsigned char* ws = ap->ws;
            pg8::SchedB1 S{((int)gridDim.x), (int)blockIdx.x, 1};
            pg8::EpiB1 E{(bf16*)(ws + WS_GR), (bf16*)(ws + WS_QA), (bf16*)(ws + WS_KA), (bf16*)(ws + WS_VA), (bf16*)(ws + WS_GTR), (bf16*)(ws + WS_GTA)};
            pg8::gemm_phase<pg8::EpiB1, pg8::SchedB1, false, true>(F.lds + RING_OFF, H1h, ws + WS_WIN + (size_t)4096 * DM, DM, DM, DM, S, E, nullptr);
        }
#endif
        GRID_BAR();
#ifdef DIAG_ATT
        if (half == DIAG_HALF) diag_pre_q(F, kargs());
        GRID_BAR();
#endif
        const int ar_slot_ = frame_vcu() % (1024 / (int)gridDim.x + 1);
#ifndef SKIP_ATT
        for (int u = frame_vcu(); u < 1024; u += ((int)gridDim.x)) { CArgs* ap = kargs(); unsigned char* ws = ap->ws;
#ifndef SKIP_B2
            if ((u - frame_vcu()) / (int)gridDim.x == ar_slot_) p_ar(F, kargs());
#endif
            const int grp = u >> 7, w = u & 127, bl = grp >> 1, kvh = grp & 1, h = kvh * 4 + (w >> 5), qb = w & 31;
            bf16* Qb = (bf16*)(ws + WS_QA) + (size_t)(bl * LT + LCTX + qb * 256) * 1024 + h * 128;
            const unsigned char* Kh = ws + WS_KA8 + ((size_t)kvh * MH + (size_t)bl * LT) * 128;
            const unsigned char* Vh = ws + WS_VA8 + ((size_t)kvh * (MH / 64) + (size_t)bl * (LT / 64)) * 8192;
            att::attn_dense_body(Qb, Kh, Vh, Qb, ws + WS_O8 + (size_t)(bl * LT + LCTX + qb * 256) * 1024 + h * 128, LT, F.lds + RING_OFF, qb * 256, ap->in[I_QN], (const float*)(ws + WS_COSA), (const float*)(ws + WS_SINA));
        }
#endif
#ifndef SKIP_B2
        if (ar_slot_ >= (1024 - frame_vcu() + (int)gridDim.x - 1) / (int)gridDim.x) p_ar(F, kargs());
#endif
        GRID_BAR();
#ifdef DIAG_ATT
        if (half == DIAG_HALF) diag_post(F, kargs(), F.lds);
        GRID_BAR();
#endif
#ifndef SKIP_C12
        for (int rep_ = 0; rep_ < REP_GC; ++rep_) { CArgs* ap = kargs(); unsigned char* ws = ap->ws;
            pg8::SchedLat S1{((int)gridDim.x), (int)blockIdx.x, 4096, 2048};
            pg8::EpiGate<false> E1{Yh, ws + WS_GTR, nullptr};
            pg8::gemm_phase<pg8::EpiGate<false>, pg8::SchedLat, false, true>(F.lds + RING_OFF, ws + WS_GR, ws + WS_WRO, 4096, 2048, 2048, S1, E1, nullptr);
            ap = kargs(); ws = ap->ws;
            pg8::SchedLat S2{((int)gridDim.x), (int)blockIdx.x, 1024, 1024};
            pg8::EpiGate<true> E2{Yh, ws + WS_GTA, Y8h};
            pg8::gemm_phase<pg8::EpiGate<true>, pg8::SchedLat, false, true>(F.lds + RING_OFF, ws + WS_O8, ws + WS_WAO, 1024, 1024, 1024, S2, E2, nullptr);
        }
#endif
        GRID_BAR();
#ifndef SKIP_C3
        for (int rep_ = 0; rep_ < REP_GC; ++rep_) { CArgs* ap = kargs(); unsigned char* ws = ap->ws;
            pg8::SchedLat S{((int)gridDim.x), (int)blockIdx.x, 1024, 1024};
            pg8::EpiOut E{ap->in[I_X], ap->out, (const float*)(ws + WS_MOD), half};
            pg8::gemm_phase<pg8::EpiOut, pg8::SchedLat, false, true>(F.lds + RING_OFF, Y8h, ws + WS_WOUT, 1024, 1024, 1024, S, E, nullptr);
        }
#endif
        if (half == 1) GRID_BAR();
#undef H1h
#undef Yh
#undef Y8h
    }

#ifndef SKIP_ROUTER
    for (int rep_ = 0; rep_ < REP_ROUTER; ++rep_) { p_router(F, kargs()); __syncthreads(); }
#endif
    GRID_BAR();
#pragma unroll 1
    for (int th = 0; th < 2; ++th) {
#ifndef SKIP_SORT
        for (int rep_ = 0; rep_ < REP_PASS; ++rep_) { p_sort(F, kargs(), th); __syncthreads(); }
#endif
        GRID_BAR();
#ifndef SKIP_M3
        for (int rep_ = 0; rep_ < REP_GM; ++rep_) { CArgs* ap = kargs(); unsigned char* ws = ap->ws;
            pg8::SchedMoe S{((int)gridDim.x), (int)blockIdx.x, 8, (const int*)(ws + WS_TILEB), (size_t)2048 * 1024, 1024, 1024, true};
            pg8::EpiSwiglu E{(unsigned char*)(ws + WS_ACT), ap->in[I_B1], (const int*)(ws + WS_TILEB)};
            pg8::gemm_phase<pg8::EpiSwiglu, pg8::SchedMoe, true, true>(F.lds + RING_OFF, ws + WS_H2, ws + WS_W1, 1024, 1024, 1024, S, E, (const int*)(ws + WS_ROWTOK));
        }
#endif
        GRID_BAR();
#ifndef SKIP_M4
        for (int rep_ = 0; rep_ < REP_GM4; ++rep_) { CArgs* ap = kargs(); unsigned char* ws = ap->ws;
            pg8::SchedMoe S{((int)gridDim.x), (int)blockIdx.x, 4, (const int*)(ws + WS_TILEB), (size_t)1024 * 1024, 1024, 1024, false};
            pg8::EpiDown E{(bf16*)(ws + WS_Y2), ap->in[I_B2], (const int*)(ws + WS_TILEB), (const float*)(ws + WS_ROWW)};
            pg8::gemm_phase<pg8::EpiDown, pg8::SchedMoe, false, true>(F.lds + RING_OFF, ws + WS_ACT, ws + WS_W2, 1024, 1024, 1024, S, E, nullptr);
        }
#endif
        GRID_BAR();
#ifndef SKIP_COMB
        p_combine(F, kargs(), th);
#endif
#ifdef DIAG_ATT
        GRID_BAR();
#endif
        __syncthreads();
    }
#ifdef DIAG_FILL
    { CArgs* ap = kargs(); const int tid = opaque_tid(); f32x4 z = {0.f, 0.f, 0.f, 0.f}; for (size_t i = (size_t)blockIdx.x * 512 + tid; i < (size_t)TTOK * DM / 4; i += (size_t)gridDim.x * 512) ((f32x4*)ap->out)[i] = z; }
    GRID_BAR();
#endif
#ifdef DIAG_ATT
    if (blockIdx.x == 0 && opaque_tid() == 0) { CArgs* ap = kargs(); const float v = __hip_atomic_load((const float*)(ap->ws + WS_DIAG_R), __ATOMIC_RELAXED, __HIP_MEMORY_SCOPE_AGENT); ap->out[0] += 1.0e6f * v; }
#endif
#undef GRID_BAR
}

extern "C" void kernel_launch(void* const* d_in, const int* in_sizes, int n_in, void* d_out, int out_size, void* d_ws, size_t ws_size, hipStream_t stream) {
    static int grid = 0;
    if (grid == 0) {
        if (n_in != 22 || in_sizes[0] != TTOK * DM || out_size != TTOK * DM || ws_size < WS_END) {
            fprintf(stderr, "kernel_launch: shape mismatch n_in %d in0 %d out %d ws %zu (need %zu)\n", n_in, n_in > 0 ? in_sizes[0] : -1, out_size, ws_size, (size_t)WS_END); grid = -1; return; }
        int dev = 0, cus = 0, per_cu = 0;
        if (hipGetDevice(&dev) != hipSuccess || hipDeviceGetAttribute(&cus, hipDeviceAttributeMultiprocessorCount, dev) != hipSuccess) { grid = -1; return; }
        if (hipFuncSetAttribute((const void*)mk_fwd, hipFuncAttributeMaxDynamicSharedMemorySize, LDS_BYTES) != hipSuccess) { fprintf(stderr, "kernel_launch: hipFuncSetAttribute failed\n"); grid = -1; return; }
        if (hipOccupancyMaxActiveBlocksPerMultiprocessor(&per_cu, (const void*)mk_fwd, NWAVES * 64, LDS_BYTES) != hipSuccess || per_cu < 1)
            fprintf(stderr, "kernel_launch: occupancy query reports %d\n", per_cu);
        (void)hipGetLastError();
        grid = cus;
    }
    if (grid < 0) return;
    if (hipMemsetAsync((char*)d_ws + WS_CTL, 0, CTL_ZERO_BYTES, stream) != hipSuccess) return;
    Args a{};
    for (int i = 0; i < 22; ++i) a.in[i] = (const float*)d_in[i];
    a.out = (float*)d_out; a.ws = (unsigned char*)d_ws;
    hipLaunchKernelGGL(mk_fwd, dim3(grid), dim3(NWAVES * 64), LDS_BYTES, stream, a);
    const hipError_t le = hipPeekAtLastError();
    if (le != hipSuccess) fprintf(stderr, "kernel_launch: launch failed: %s\n", hipGetErrorName(le));
}
```

```cpp
#include <hip/hip_runtime.h>
#include <cstdio>
#include <cstdint>
#include <cstring>

#define GAS __attribute__((address_space(1)))
#define LAS __attribute__((address_space(3)))
#define DI __device__ __forceinline__
typedef unsigned short bf16;
typedef unsigned v4u __attribute__((ext_vector_type(4)));
typedef unsigned v2u __attribute__((ext_vector_type(2)));
typedef float f32x4 __attribute__((ext_vector_type(4)));
typedef float f32x2 __attribute__((ext_vector_type(2)));
typedef float f32x16 __attribute__((ext_vector_type(16)));
typedef short bf16x8 __attribute__((ext_vector_type(8)));
typedef short s16x4 __attribute__((ext_vector_type(4)));
typedef GAS unsigned gu32;
#define RLX_AGENT __ATOMIC_RELAXED, __HIP_MEMORY_SCOPE_AGENT
#define LDS_WAIT() asm volatile("s_waitcnt lgkmcnt(0)" ::: "memory")
#define VM_WAIT() asm volatile("s_waitcnt vmcnt(0)" ::: "memory")

constexpr int NB = 8, SEQ = 8192, DM = 1024, LCTX = 256;
constexpr int LT = SEQ + LCTX;
constexpr int TTOK = NB * SEQ;
constexpr int MROWS = NB * LT;
constexpr int NBH = 4;
constexpr int MH = NBH * LT;
constexpr int TPB = LT / 256;
constexpr int INW = 9728;
constexpr int NEXP = 32, EFF = 1024;
constexpr float EPS = 1e-6f;
constexpr int NWAVES = 8;

constexpr size_t MiB = 1u << 20;
constexpr size_t WS_CTL = 0, CTL_ZERO_BYTES = 1 * MiB;
constexpr size_t WS_SMALL = 1 * MiB;
constexpr size_t WS_MOD   = WS_SMALL;
constexpr size_t WS_COSR  = WS_SMALL + 256 * 1024;
constexpr size_t WS_SINR  = WS_COSR + 32 * 1024;
constexpr size_t WS_COSA  = WS_SINR + 32 * 1024;
constexpr size_t WS_SINA  = WS_COSA + 16 * 1024;
constexpr size_t WS_TOPE  = WS_SMALL + 1 * MiB;
constexpr size_t WS_TOPW  = WS_SMALL + 2 * MiB;
constexpr size_t WS_WCNT  = WS_SMALL + 3 * MiB;
constexpr size_t WS_ROWTOK = WS_SMALL + 4 * MiB;
constexpr size_t WS_ROWDST = WS_SMALL + 5 * MiB;
constexpr size_t WS_ROWW  = WS_SMALL + 6 * MiB;
constexpr size_t WS_TILEB = WS_SMALL + 7 * MiB;
constexpr size_t WS_PART  = WS_SMALL + 8 * MiB;
constexpr size_t WS_WIN  = 17 * MiB;
constexpr size_t WS_WRO  = 36 * MiB;
constexpr size_t WS_WAO  = 40 * MiB;
constexpr size_t WS_WOUT = 42 * MiB;
constexpr size_t WS_W1   = 44 * MiB;
constexpr size_t WS_W2   = 172 * MiB;
constexpr size_t WS_H1   = 236 * MiB;
constexpr size_t WS_Y    = 302 * MiB;
constexpr size_t WS_QR = 368 * MiB, WS_KR = 434 * MiB, WS_VR = 500 * MiB;
constexpr size_t WS_OF = 632 * MiB, WS_OB = 764 * MiB;
constexpr size_t WS_GR = 368 * MiB, WS_QA = 500 * MiB, WS_GTR = 566 * MiB, WS_GTA = 896 * MiB, WS_KA = 962 * MiB, WS_VA = 979 * MiB;
constexpr size_t WS_KA8 = 996 * MiB;
constexpr size_t WS_VA8 = 1005 * MiB;
constexpr size_t WS_O8 = WS_KA;
constexpr size_t WS_END = 1014 * MiB;
constexpr size_t WS_H2 = 236 * MiB;
constexpr size_t WS_ACT = 368 * MiB;
constexpr size_t WS_Y2 = 640 * MiB;
constexpr int TH_TOK = TTOK / 2;
constexpr int ACT_CAP = TH_TOK * 4 + 32 * 256;
static_assert(WS_VA + (size_t)MH * 256 * 2 <= WS_END && WS_KA + (size_t)MH * 256 * 2 <= WS_VA, "ws map");
static_assert(WS_Y2 + (size_t)ACT_CAP * 1024 * 2 <= WS_KA8 && WS_ACT + (size_t)ACT_CAP * 2048 <= WS_Y2, "ws map moe");
constexpr int CW_TMO = 0, CW_CODE = 1;
constexpr int CW_BAR = 4096;

constexpr int RING_OFF = 0, RING_BYTES = 159744;
constexpr int LDSCTL_OFF = RING_BYTES, MISC_OFF = LDSCTL_OFF + 320;
constexpr int LDS_BYTES = 163840;

DI unsigned cvt_pk_bf16(float lo, float hi) { unsigned r; asm volatile("v_cvt_pk_bf16_f32 %0, %1, %2" : "=v"(r) : "v"(lo), "v"(hi)); return r; }
DI unsigned pk4_fp8(float a, float b, float c, float d) { int p = 0; p = __builtin_amdgcn_cvt_pk_fp8_f32(a, b, p, false); p = __builtin_amdgcn_cvt_pk_fp8_f32(c, d, p, true); return (unsigned)p; }
DI float bf_lo(unsigned u) { return __uint_as_float(u << 16); }
DI float bf_hi(unsigned u) { return __uint_as_float(u & 0xffff0000u); }
template <int O> DI float lane_xor(float v) { static_assert(O > 0 && O < 32, "lane_xor"); return __int_as_float(__builtin_amdgcn_ds_swizzle(__float_as_int(v), 0x1f | (O << 10))); }
DI float wave_sum(float v) {
    v += lane_xor<1>(v); v += lane_xor<2>(v); v += lane_xor<4>(v); v += lane_xor<8>(v); v += lane_xor<16>(v);
    auto rr = __builtin_amdgcn_permlane32_swap(__float_as_uint(v), __float_as_uint(v), false, false);
    return __uint_as_float(rr[0]) + __uint_as_float(rr[1]);
}
DI float fast_sigmoid(float x) { return __builtin_amdgcn_rcpf(1.0f + __expf(-x)); }

DI int hw_wave_key() { return (int)__builtin_amdgcn_s_getreg((5 << 11) | 4) & 63; }
DI int opaque_tid() {
    int w = *(volatile LAS int*)(uintptr_t)(LDSCTL_OFF + 4 * hw_wave_key());
    w = __builtin_amdgcn_readfirstlane(w);
    unsigned z; asm volatile("v_mov_b32 %0, 0" : "=v"(z));
    int t = w * 64 + (int)__builtin_amdgcn_mbcnt_hi(~0u, __builtin_amdgcn_mbcnt_lo(~0u, z));
    asm volatile("" : "+v"(t)); return t;
}

DI int fresh_lane() { unsigned z; asm volatile("v_mov_b32 %0, 0" : "=v"(z)); int l = (int)__builtin_amdgcn_mbcnt_hi(~0u, __builtin_amdgcn_mbcnt_lo(~0u, z)); asm volatile("" : "+v"(l)); return l; }

#define XB_TMO      128
#define XB_XCNT(j)  (256  + 64 * (j))
#define XB_XSUB(j)  (1280 + 64 * (j))
#define XB_XGEN(j)  (2304 + 64 * (j))
#define XB_TOP      3328
#define XB_TOPGEN   3392
#define XCD_BAR_WORDS 3456
#define XB_SPIN_CAP (1u << 18)

__device__ __forceinline__ unsigned xb_ld(unsigned* p)              { return __hip_atomic_load(p, __ATOMIC_RELAXED, __HIP_MEMORY_SCOPE_AGENT); }
__device__ __forceinline__ unsigned xb_add(unsigned* p, unsigned v) { return __hip_atomic_fetch_add(p, v, __ATOMIC_RELAXED, __HIP_MEMORY_SCOPE_AGENT); }
__device__ __forceinline__ unsigned xb_xcc_id() { return (unsigned)__builtin_amdgcn_s_getreg((3 << 11) | 20) & 0xFu; }
#define XB_SPIN(cond, bar) do { unsigned _sp = 0; while (cond) { __builtin_amdgcn_s_sleep(1); \
    if ((++_sp & 255u) == 0u) { if (xb_ld(&(bar)[XB_TMO])) break; if (_sp > XB_SPIN_CAP) { atomicAdd(&(bar)[XB_TMO], 1u); break; } } } } while (0)

struct XcdBarrier {
    unsigned* bar; unsigned x;
    volatile LAS unsigned* st;
};

__device__ __forceinline__ XcdBarrier xcd_barrier_post(unsigned* bar, volatile LAS unsigned* st) {
    XcdBarrier b; b.bar = bar; b.x = xb_xcc_id(); b.st = st;
    if (opaque_tid() == 0) (void)xb_add(&bar[XB_XCNT(b.x)], 1u);
    return b;
}
__device__ __forceinline__ void xcd_barrier_complete(unsigned* bar, unsigned x, unsigned& nloc, unsigned& nx) {
    const unsigned G = gridDim.x * gridDim.y * gridDim.z;
    unsigned sum, cnt, mine, sp = 0u;
    for (;;) {
        sum = 0u; cnt = 0u; mine = 0u;
#pragma unroll
        for (unsigned j = 0; j < 16; ++j) { const unsigned c = xb_ld(&bar[XB_XCNT(j)]); sum += c; cnt += (c > 0u) ? 1u : 0u; mine = (j == x) ? c : mine; }
        if (sum == G) break;
        __builtin_amdgcn_s_sleep(1);
        if ((++sp & 255u) == 0u) { if (xb_ld(&bar[XB_TMO])) break; if (sp > XB_SPIN_CAP) { atomicAdd(&bar[XB_TMO], 1u); break; } }
    }
    nloc = mine > 0u ? mine : 1u; nx = cnt > 0u ? cnt : 1u;
}

__device__ __forceinline__ void xcd_barrier(const XcdBarrier& b) {
    asm volatile("s_waitcnt vmcnt(0)" ::: "memory");
    __syncthreads();
    if (opaque_tid() == 0) {
        unsigned* bar = b.bar;
        __builtin_amdgcn_s_waitcnt(0);
        unsigned nloc = b.st[0], nx = b.st[1];
        if (nloc == 0u) { xcd_barrier_complete(bar, b.x, nloc, nx); b.st[0] = nloc; b.st[1] = nx; }
        const unsigned old = xb_add(&bar[XB_XSUB(b.x)], 1u);
        const unsigned gen = old / nloc;
        if (old + 1u == (gen + 1u) * nloc) {
            __builtin_amdgcn_fence(__ATOMIC_RELEASE, "agent");
            asm volatile("s_waitcnt vmcnt(0)" ::: "memory");
            const unsigned og = xb_add(&bar[XB_TOP], 1u);
            const unsigned tg = og / nx;
            if (og + 1u == (tg + 1u) * nx) xb_add(&bar[XB_TOPGEN], 1u);
            else XB_SPIN(xb_ld(&bar[XB_TOPGEN]) == tg, bar);
            __builtin_amdgcn_fence(__ATOMIC_ACQUIRE, "agent");
            xb_add(&bar[XB_XGEN(b.x)], 1u);
            asm volatile("s_waitcnt vmcnt(0)" ::: "memory");
        } else {
            XB_SPIN(xb_ld(&bar[XB_XGEN(b.x)]) == gen, bar);
            __builtin_amdgcn_fence(__ATOMIC_ACQUIRE, "agent");
            asm volatile("s_waitcnt vmcnt(0)" ::: "memory");
        }
    }
    __syncthreads();
}
namespace pg8 {
#define PG8_LAS __attribute__((address_space(3)))
constexpr int BM = 256, BK = 64, HALF = 128, HTB = HALF * BK * 2, STAGE_BYTES = 8 * HTB, NXCD = 8, WGM = 8;
__host__ __device__ __forceinline__ int lds_byte(int r, int c) { const int st = (r >> 4) * 2 + (c >> 5), rr = r & 15, cc = c & 31, ob = rr * 64 + cc * 2; return st * 1024 + (ob ^ (((ob >> 9) & 1) << 5)); }
__host__ __device__ __forceinline__ void stage_rc(int b, int& R, int& C) { const int st = b / 1024, sb = b % 1024, swz = sb ^ (((sb >> 9) & 1) << 5); R = (st >> 1) * 16 + swz / 64; C = (st & 1) * 32 + (swz % 64) / 2; }
__host__ __device__ __forceinline__ int perm32(int rho) { const int n = rho >> 4, i = rho & 15; return 8 * (i >> 2) + 4 * n + (i & 3); }

struct Unit { int pm, pn; size_t aoff, boff; int grow; };

DI void tile_order(int L, int nM, int nN, int& pm, int& pn) {
    const int nwg = nM * nN; int wgid = L;
    { const int q = nwg / NXCD, r = nwg % NXCD, xcd = wgid % NXCD, off = wgid / NXCD; wgid = (xcd < r ? xcd * (q + 1) : r * (q + 1) + (xcd - r) * q) + off; }
    const int nig = WGM * nN, gid = wgid / nig, fm = gid * WGM, gsz = (nM - fm) < WGM ? (nM - fm) : WGM;
    pm = fm + ((wgid % nig) % gsz); pn = (wgid % nig) / gsz;
}

typedef int v8i32 __attribute__((ext_vector_type(8)));
template <class Epi, class Sched, bool GATHER, bool FP8 = false>
__device__ __forceinline__ void gemm_phase(PG8_LAS unsigned char* lds, const void* A, const void* Bt, const int lda_e, const int ldb_e, const int K, const Sched& S, const Epi& E, const int* __restrict__ gtab) {
    constexpr int ESZ = FP8 ? 1 : 2; const int lda = lda_e * ESZ, ldb = ldb_e * ESZ;
    const int tid = opaque_tid(), wid = __builtin_amdgcn_readfirstlane(tid >> 6), lane = tid & 63, wr = wid >> 2, wc = wid & 3, fr = lane & 15, fq = lane >> 4;
    const int nt = K * ESZ / (BK * 2);
    unsigned voffA[2], voffB[2]; int stR[2], stC[2];
#pragma unroll
    for (int i = 0; i < 2; ++i) { int R, C; stage_rc(tid * 16 + i * 8192, R, C); const int Rb = Epi::PERM ? ((R & ~31) + perm32(R & 31)) : R;
        stR[i] = R; stC[i] = C; voffA[i] = (unsigned)(R * lda + C * 2); voffB[i] = (unsigned)(Rb * ldb + C * 2); }
    const size_t kstep = (size_t)(BK * 2);
    const size_t hstepA = (size_t)HALF * lda, hstepB = (size_t)HALF * ldb;
    const unsigned ldsw = (unsigned)wid * 1024u;
    int aoff = lds_byte(wr * 64 + fr, fq * 8); asm volatile("" : "+v"(aoff));
    int boff = lds_byte(wc * 32 + fr, fq * 8) + 4 * HTB;
    asm volatile("" : "+v"(boff));
#define PG8_SA(b, h) (((b) * 2 + (h)) * HTB)
#define PG8_SB(b, h) ((4 + (b) * 2 + (h)) * HTB)
#define PG8_SBR(b, h) (((b) * 2 + (h)) * HTB)
#define PG8_STAGE(bufoff, gbase, voff) do { _Pragma("unroll") for (int _i = 0; _i < 2; ++_i) { unsigned _vo = (voff)[_i]; asm volatile("" : "+v"(_vo)); \
        __builtin_amdgcn_global_load_lds((const unsigned*)((const char*)(gbase) + _vo), (PG8_LAS unsigned*)(lds + (bufoff) + ldsw + _i * 8192), 16, 0, 0); } } while (0)
#define PG8_STAGE_A(bufoff, p, h, go) do { if constexpr (GATHER) { _Pragma("unroll") for (int _i = 0; _i < 2; ++_i) { unsigned _vo = (go)[(h) * 2 + _i]; asm volatile("" : "+v"(_vo)); \
        __builtin_amdgcn_global_load_lds((const unsigned*)((const char*)(p) + _vo), (PG8_LAS unsigned*)(lds + (bufoff) + ldsw + _i * 8192), 16, 0, 0); } } \
        else { PG8_STAGE(bufoff, (p) + (h) * hstepA, voffA); } } while (0)
#define PG8_LD16(off) (*(const PG8_LAS v4u*)(lds + (off)))
#define PG8_LDA(dst, b, h) do { _Pragma("unroll") for (int m = 0; m < 4; ++m) dst[m] = __builtin_shufflevector(PG8_LD16(PG8_SA(b, h) + aoff + m * 2048), PG8_LD16(PG8_SA(b, h) + aoff + m * 2048 + 1024), 0, 1, 2, 3, 4, 5, 6, 7); } while (0)
#define PG8_LDB(dst, b, h) do { _Pragma("unroll") for (int n = 0; n < 2; ++n) dst[n] = __builtin_shufflevector(PG8_LD16(PG8_SBR(b, h) + boff + n * 2048), PG8_LD16(PG8_SBR(b, h) + boff + n * 2048 + 1024), 0, 1, 2, 3, 4, 5, 6, 7); } while (0)
#define PG8_HALF(x, k) __builtin_bit_cast(bf16x8, __builtin_shufflevector((x), (x), 4 * (k), 4 * (k) + 1, 4 * (k) + 2, 4 * (k) + 3))
#define PG8_MMA(ai, bj, At, Bt_) do { __builtin_amdgcn_s_setprio(1); _Pragma("unroll") for (int m = 0; m < 4; ++m) _Pragma("unroll") for (int n = 0; n < 2; ++n) { \
        if constexpr (FP8) acc[ai][bj][m][n] = __builtin_amdgcn_mfma_scale_f32_16x16x128_f8f6f4(__builtin_bit_cast(v8i32, Bt_[n]), __builtin_bit_cast(v8i32, At[m]), acc[ai][bj][m][n], 0, 0, 0, 0x7c7c7c7c, 0, 0x7c7c7c7c);   \
        else { acc[ai][bj][m][n] = __builtin_amdgcn_mfma_f32_16x16x32_bf16(PG8_HALF(Bt_[n], 0), PG8_HALF(At[m], 0), acc[ai][bj][m][n], 0, 0, 0); \
               acc[ai][bj][m][n] = __builtin_amdgcn_mfma_f32_16x16x32_bf16(PG8_HALF(Bt_[n], 1), PG8_HALF(At[m], 1), acc[ai][bj][m][n], 0, 0, 0); } } \
        __builtin_amdgcn_s_setprio(0); } while (0)
#define PG8_WAIT_V(n) asm volatile("s_waitcnt vmcnt(" #n ")" ::: "memory")
#define PG8_WAIT_L(n) asm volatile("s_waitcnt lgkmcnt(" #n ")" ::: "memory")
#define PG8_BAR __builtin_amdgcn_s_barrier()
#define PG8_SCHED __builtin_amdgcn_sched_barrier(0)
#define PG8_GOFF(dst, u) do { if constexpr (GATHER) { _Pragma("unroll") for (int _h = 0; _h < 2; ++_h) _Pragma("unroll") for (int _i = 0; _i < 2; ++_i) \
        dst[_h * 2 + _i] = (unsigned)(gtab[(u).grow + _h * HALF + stR[_i]] * lda + stC[_i] * 2); } } while (0)
    Unit cur, nxt; int ui = 0;
    if (!S.next(0, cur)) return;
    f32x4 acc[2][2][4][2];
#pragma unroll
    for (int a = 0; a < 2; ++a)
#pragma unroll
        for (int b = 0; b < 2; ++b)
#pragma unroll
            for (int m = 0; m < 4; ++m)
#pragma unroll
                for (int n = 0; n < 2; ++n) acc[a][b][m][n] = (f32x4){0.f, 0.f, 0.f, 0.f};
    typedef unsigned v8u __attribute__((ext_vector_type(8)));
    v8u At[4], B0[2], B1[2];
    unsigned gC[4] = {0u, 0u, 0u, 0u}, gN[4] = {0u, 0u, 0u, 0u};
    const char* cA = (const char*)A + cur.aoff; const char* cB = (const char*)Bt + cur.boff;
    PG8_GOFF(gC, cur);
    PG8_STAGE(PG8_SB(0, 0), cB, voffB); PG8_STAGE(PG8_SB(0, 1), cB + hstepB, voffB); PG8_STAGE_A(PG8_SA(0, 0), cA, 0, gC); PG8_STAGE_A(PG8_SA(0, 1), cA, 1, gC);
    if (wr == 1) PG8_BAR;
    PG8_WAIT_V(2); PG8_BAR;
    PG8_STAGE(PG8_SB(1, 0), cB + kstep, voffB); PG8_STAGE_A(PG8_SA(1, 0), cA + kstep, 0, gC); PG8_STAGE(PG8_SB(1, 1), cB + hstepB + kstep, voffB);
    PG8_WAIT_V(6); PG8_BAR;
    for (;;) {
        const bool has_next = S.next(ui + 1, nxt);
        const char* nA = has_next ? (const char*)A + nxt.aoff : cA; const char* nB = has_next ? (const char*)Bt + nxt.boff : cB;
        if constexpr (GATHER) { if (has_next) { PG8_GOFF(gN, nxt); } else {
#pragma unroll
            for (int q = 0; q < 4; ++q) gN[q] = gC[q]; } }
#pragma unroll 1
        for (int t = 0; t < nt; t += 2) {
            const bool last = (t == nt - 2);
            const char* a1 = cA + (size_t)(t + 1) * kstep;
            const char* a2 = last ? nA : cA + (size_t)(t + 2) * kstep; const char* b2 = last ? nB : cB + (size_t)(t + 2) * kstep;
            const char* a3 = a2 + kstep; const char* b3 = b2 + kstep;
            PG8_LDB(B0, 0, 0); PG8_LDB(B1, 0, 1); PG8_SCHED; PG8_LDA(At, 0, 0); PG8_STAGE_A(PG8_SA(1, 1), a1, 1, gC);
            if constexpr (GATHER) { if (last) {
#pragma unroll
                for (int q = 0; q < 4; ++q) gC[q] = gN[q]; } }
            PG8_WAIT_V(8); PG8_WAIT_L(0); PG8_BAR; PG8_MMA(0, 0, At, B0); PG8_MMA(0, 1, At, B1); PG8_BAR; PG8_SCHED;
            PG8_LDA(At, 0, 1); PG8_STAGE(PG8_SB(0, 0), b2, voffB); PG8_STAGE(PG8_SB(0, 1), b2 + hstepB, voffB); PG8_STAGE_A(PG8_SA(0, 0), a2, 0, gC);
            PG8_WAIT_V(8); PG8_WAIT_L(0); PG8_BAR; PG8_MMA(1, 0, At, B0); PG8_MMA(1, 1, At, B1); PG8_BAR; PG8_SCHED;
            PG8_LDB(B0, 1, 0); PG8_LDB(B1, 1, 1); PG8_SCHED; PG8_LDA(At, 1, 0); PG8_STAGE_A(PG8_SA(0, 1), a2, 1, gC);
            PG8_WAIT_V(8); PG8_WAIT_L(0); PG8_BAR; PG8_MMA(0, 0, At, B0); PG8_MMA(0, 1, At, B1); PG8_BAR; PG8_SCHED;
            PG8_LDA(At, 1, 1); PG8_STAGE(PG8_SB(1, 0), b3, voffB); PG8_STAGE(PG8_SB(1, 1), b3 + hstepB, voffB); PG8_STAGE_A(PG8_SA(1, 0), a3, 0, gC);
            PG8_WAIT_V(8); PG8_WAIT_L(0); PG8_BAR; PG8_MMA(1, 0, At, B0); PG8_MMA(1, 1, At, B1); PG8_BAR; PG8_SCHED;
        }
        if (wr == 0) PG8_BAR;
        { const int le = fresh_lane(); E(acc, cur, wr, wc, le & 15, le >> 4); }
        if (!has_next) break;
#pragma unroll
        for (int a = 0; a < 2; ++a)
#pragma unroll
            for (int b = 0; b < 2; ++b)
#pragma unroll
                for (int m = 0; m < 4; ++m)
#pragma unroll
                    for (int n = 0; n < 2; ++n) acc[a][b][m][n] = (f32x4){0.f, 0.f, 0.f, 0.f};
        cur = nxt; cA = nA; cB = nB; ++ui;
        if (wr == 1) PG8_BAR;
    }
    PG8_WAIT_V(0);
    PG8_BAR;
#undef PG8_SA
#undef PG8_SB
#undef PG8_SBR
#undef PG8_STAGE
#undef PG8_STAGE_A
#undef PG8_LDA
#undef PG8_LDB
#undef PG8_MMA
#undef PG8_HALF
#undef PG8_LD16
#undef PG8_WAIT_V
#undef PG8_WAIT_L
#undef PG8_BAR
#undef PG8_SCHED
#undef PG8_GOFF
}
}

namespace pg8 {
DI v4u pack8(const f32x4& v0, const f32x4& v1) { v4u w; w.x = cvt_pk_bf16(v0[0], v0[1]); w.y = cvt_pk_bf16(v0[2], v0[3]); w.z = cvt_pk_bf16(v1[0], v1[1]); w.w = cvt_pk_bf16(v1[2], v1[3]); return w; }
DI void unpack8(const v4u w, f32x4& v0, f32x4& v1) { v0 = (f32x4){bf_lo(w.x), bf_hi(w.x), bf_lo(w.y), bf_hi(w.y)}; v1 = (f32x4){bf_lo(w.z), bf_hi(w.z), bf_lo(w.w), bf_hi(w.w)}; }

struct SchedA1 {
    int G, c; size_t esz;
    DI bool next(int i, Unit& u) const {
        const long L = (long)i * G + c; const int n1 = 132 * 12, n2 = 132 * 2, n3 = 128 * 4;
        if (L >= n1 + n2 + n3) return false;
        int pm, pn;
        if (L < n1) { tile_order((int)L, 132, 12, pm, pn); pn += 4; }
        else if (L < n1 + n2) { tile_order((int)L - n1, 132, 2, pm, pn); pn += 28; }
        else { int pl; tile_order((int)L - n1 - n2, 128, 4, pl, pn); pm = (pl >> 5) * TPB + 1 + (pl & 31); }
        u.pm = pm; u.pn = pn; u.aoff = (size_t)pm * 256 * DM * esz; u.boff = (size_t)pn * 256 * DM * esz; u.grow = 0; return true;
    }
};
struct EpiA1 {
    static constexpr bool PERM = true;
    bf16 *QR, *KR, *VR, *KA, *VA; const float *cosr, *sinr;
    DI void operator()(const f32x4 (&acc)[2][2][4][2], const Unit& u, int wr, int wc, int fr, int fq) const {
        const int pn = u.pn; const int tin = u.pm % TPB;
        if (pn >= 8) {
            const int ldc = pn >= 28 ? 256 : 2048;
            bf16* base = (pn == 28 ? KA : (pn == 29 ? VA : VR + (pn - 8) * 256)) + (size_t)(u.pm * 256 + wr * 64 + fr) * ldc + wc * 32 + 8 * fq;
#pragma unroll
            for (int ai = 0; ai < 2; ++ai)
#pragma unroll
                for (int m = 0; m < 4; ++m)
#pragma unroll
                    for (int bj = 0; bj < 2; ++bj) __builtin_nontemporal_store(pack8(acc[ai][bj][m][0], acc[ai][bj][m][1]), (v4u*)(base + (size_t)(ai * 128 + m * 16) * ldc + bj * 128));
            return;
        }
        const bool isk = pn >= 4; const float sc = isk ? 0.0625f : 1.0f; const bool rope = tin != 0;
        const int hd = pn & 3, R0 = u.pm * 256 + wr * 64 + fr;
        const int axis = wc >> 1, f0 = 32 * (wc & 1) + 8 * fq;
#pragma unroll
        for (int ai = 0; ai < 2; ++ai)
#pragma unroll
            for (int m = 0; m < 4; ++m) {
                f32x4 o1[2], o2[2];
                if (rope) {
                    const int t = (tin - 1) * 256 + ai * 128 + wr * 64 + m * 16 + fr;
                    const int pos = axis ? (t & 63) : (t >> 6);
#pragma unroll
                    for (int n = 0; n < 2; ++n) {
                        const f32x4 cs = *(const f32x4*)(cosr + pos * 64 + f0 + 4 * n), sn = *(const f32x4*)(sinr + pos * 64 + f0 + 4 * n);
                        const f32x4 x1 = acc[ai][0][m][n], x2 = acc[ai][1][m][n];
                        o1[n] = (x1 * cs - x2 * sn) * sc; o2[n] = (x2 * cs + x1 * sn) * sc;
                    }
                } else {
#pragma unroll
                    for (int n = 0; n < 2; ++n) { o1[n] = acc[ai][0][m][n] * sc; o2[n] = acc[ai][1][m][n] * sc; }
                }
                const int R = R0 + ai * 128 + m * 16;
                if (isk) { bf16* rp = KR + ((size_t)((R >> 6) * 4 + hd) * 2) * 8192 + ((4 * wc + fq) * 64 + (R & 63)) * 8;
                    __builtin_nontemporal_store(pack8(o1[0], o1[1]), (v4u*)(rp)); __builtin_nontemporal_store(pack8(o2[0], o2[1]), (v4u*)(rp + 8192)); }
                else { bf16* rp = QR + (size_t)((R >> 5) * 4 + hd) * 8192 + ((2 * wc + (fq >> 1)) * 64 + (fq & 1) * 32 + (R & 31)) * 8;
                    __builtin_nontemporal_store(pack8(o1[0], o1[1]), (v4u*)(rp)); __builtin_nontemporal_store(pack8(o2[0], o2[1]), (v4u*)(rp + 8 * 64 * 8)); }
            }
    }
};

struct SchedB1 {
    int G, c; size_t esz;
    DI bool next(int i, Unit& u) const {
        const long L = (long)i * G + c; const int n1 = 128 * 20;
        if (L >= n1) return false;
        int pm, pn;
        { int pl; tile_order((int)L, 128, 20, pl, pn); pm = (pl >> 5) * TPB + 1 + (pl & 31); if (pn >= 12) pn += 2; }
        u.pm = pm; u.pn = pn; u.aoff = (size_t)pm * 256 * DM * esz; u.boff = (size_t)pn * 256 * DM * esz; u.grow = 0; return true;
    }
};
DI size_t gt_frag_off(int pm, int pnl, int wr, int wc, int fr, int fq) { return ((size_t)((pm * 4 + pnl) * 8 + wr * 4 + wc) * 16) * 512 + (size_t)(fq * 16 + fr) * 8; }
struct EpiB1 {
    static constexpr bool PERM = true;
    bf16 *GR, *QA, *KA, *VA, *GTR, *GTA;
    DI void operator()(const f32x4 (&acc)[2][2][4][2], const Unit& u, int wr, int wc, int fr, int fq) const {
        const int pn = u.pn; bf16* dst; int ldc, col0, act;
        if (pn < 8) { dst = GR; ldc = 2048; col0 = pn * 256; act = 1; }
        else if (pn < 12) { dst = QA; ldc = 1024; col0 = (pn - 8) * 256; act = 0; }
        else if (pn == 12) { dst = KA; ldc = 256; col0 = 0; act = 0; }
        else if (pn == 13) { dst = VA; ldc = 256; col0 = 0; act = 0; }
        else if (pn < 18) { dst = GTR; ldc = 1024; col0 = (pn - 14) * 256; act = 2; }
        else { dst = GTA; ldc = 1024; col0 = (pn - 18) * 256; act = 2; }
        bf16* base = dst + (size_t)(u.pm * 256 + wr * 64 + fr) * ldc + col0 + wc * 32 + 8 * fq;
#pragma unroll
        for (int ai = 0; ai < 2; ++ai)
#pragma unroll
            for (int m = 0; m < 4; ++m)
#pragma unroll
                for (int bj = 0; bj < 2; ++bj) {
                    f32x4 v0 = acc[ai][bj][m][0], v1 = acc[ai][bj][m][1];
                    if (act) {
#pragma unroll
                        for (int j = 0; j < 4; ++j) { const float s0 = fast_sigmoid(v0[j]), s1 = fast_sigmoid(v1[j]); v0[j] = act == 1 ? v0[j] * s0 : s0; v1[j] = act == 1 ? v1[j] * s1 : s1; }
                    }
                    if (act == 2) { v2u q; q.x = pk4_fp8(v0[0], v0[1], v0[2], v0[3]); q.y = pk4_fp8(v1[0], v1[1], v1[2], v1[3]);
                        __builtin_nontemporal_store(q, (v2u*)((unsigned char*)dst + gt_frag_off(u.pm, (pn - 14) & 3, wr, wc, fr, fq) + (size_t)(ai * 8 + m * 2 + bj) * 512)); }
                    else __builtin_nontemporal_store(pack8(v0, v1), (v4u*)(base + (size_t)(ai * 128 + m * 16) * ldc + bj * 128));
                }
    }
};

struct SchedLat {
    int G, c, lda, ldb;
    DI bool next(int i, Unit& u) const {
        const long L = (long)i * G + c; if (L >= 128 * 4) return false;
        int pl, pn; tile_order((int)L, 128, 4, pl, pn); const int pm = (pl >> 5) * TPB + 1 + (pl & 31);
        u.pm = pm; u.pn = pn; u.aoff = (size_t)pm * 256 * lda; u.boff = (size_t)pn * 256 * ldb; u.grow = pl; return true;
    }
};
template <bool ADD> struct EpiGate {
    static constexpr bool PERM = true;
    bf16* Y; const unsigned char* Gt; unsigned char* Y8;
    DI void operator()(const f32x4 (&acc)[2][2][4][2], const Unit& u, int wr, int wc, int fr, int fq) const {
        const size_t off0 = (size_t)(u.pm * 256 + wr * 64 + fr) * 1024 + u.pn * 256 + wc * 32 + 8 * fq, goff0 = gt_frag_off(u.pm, u.pn, wr, wc, fr, fq);
#pragma unroll
        for (int ai = 0; ai < 2; ++ai) {
            v2u gq[4][2]; v4u yq[4][2];
#pragma unroll
            for (int m = 0; m < 4; ++m)
#pragma unroll
                for (int bj = 0; bj < 2; ++bj) { const size_t off = off0 + (size_t)(ai * 128 + m * 16) * 1024 + bj * 128; gq[m][bj] = *(const v2u*)(Gt + goff0 + (size_t)(ai * 8 + m * 2 + bj) * 512); if (ADD) yq[m][bj] = *(const v4u*)(Y + goff0 + (size_t)(ai * 8 + m * 2 + bj) * 512); }
#pragma unroll
            for (int m = 0; m < 4; ++m)
#pragma unroll
                for (int bj = 0; bj < 2; ++bj) {
                    const size_t off = off0 + (size_t)(ai * 128 + m * 16) * 1024 + bj * 128;
                    f32x4 g0, g1; { const auto l0 = __builtin_amdgcn_cvt_pk_f32_fp8((int)gq[m][bj].x, false), h0 = __builtin_amdgcn_cvt_pk_f32_fp8((int)gq[m][bj].x, true), l1 = __builtin_amdgcn_cvt_pk_f32_fp8((int)gq[m][bj].y, false), h1 = __builtin_amdgcn_cvt_pk_f32_fp8((int)gq[m][bj].y, true);
                        g0 = (f32x4){l0[0], l0[1], h0[0], h0[1]}; g1 = (f32x4){l1[0], l1[1], h1[0], h1[1]}; }
                    f32x4 v0 = acc[ai][bj][m][0] * g0, v1 = acc[ai][bj][m][1] * g1;
                    if (ADD) { f32x4 y0, y1; unpack8(yq[m][bj], y0, y1); v0 = (v0 + y0) * 4.0f; v1 = (v1 + y1) * 4.0f; v2u q;
#define YQ(v) __builtin_amdgcn_fmed3f((v), -448.f, 448.f)
                        q.x = pk4_fp8(YQ(v0[0]), YQ(v0[1]), YQ(v0[2]), YQ(v0[3])); q.y = pk4_fp8(YQ(v1[0]), YQ(v1[1]), YQ(v1[2]), YQ(v1[3]));
#undef YQ
                        *(v2u*)(Y8 + off) = q; }
                    else *(v4u*)(Y + goff0 + (size_t)(ai * 8 + m * 2 + bj) * 512) = pack8(v0, v1);
                }
            asm volatile("" ::: "memory");
        }
    }
};
struct EpiOut {
    static constexpr bool PERM = false;
    const float* x; float* out; const float* mod; int half;
    DI void operator()(const f32x4 (&acc)[2][2][4][2], const Unit& u, int wr, int wc, int fr, int fq) const {
        const int pl = u.grow, b = half * NBH + (pl >> 5); const size_t tok0 = (size_t)b * SEQ + (size_t)(pl & 31) * 256 + wr * 64 + fr;
        const int col0 = u.pn * 256 + wc * 32 + 4 * fq; const float* g1 = mod + (size_t)b * 6144 + 2048 + col0;
        f32x4 gv[2][2];
#pragma unroll
        for (int bj = 0; bj < 2; ++bj)
#pragma unroll
            for (int n = 0; n < 2; ++n) gv[bj][n] = *(const f32x4*)(g1 + bj * 128 + n * 16);
#pragma unroll
        for (int ai = 0; ai < 2; ++ai)
#pragma unroll
            for (int mp = 0; mp < 2; ++mp) {
                f32x4 xq[2][2][2];
#pragma unroll
                for (int mm = 0; mm < 2; ++mm) { const size_t off = (tok0 + ai * 128 + (2 * mp + mm) * 16) * DM + col0;
#pragma unroll
                    for (int bj = 0; bj < 2; ++bj)
#pragma unroll
                        for (int n = 0; n < 2; ++n) xq[mm][bj][n] = *(const f32x4*)(x + off + bj * 128 + n * 16); }
#pragma unroll
                for (int mm = 0; mm < 2; ++mm) { const int m = 2 * mp + mm; const size_t off = (tok0 + ai * 128 + m * 16) * DM + col0;
#pragma unroll
                    for (int bj = 0; bj < 2; ++bj)
#pragma unroll
                        for (int n = 0; n < 2; ++n) { const f32x4 r = xq[mm][bj][n] + gv[bj][n] * acc[ai][bj][m][n]; v2u w; w.x = cvt_pk_bf16(r[0], r[1]); w.y = cvt_pk_bf16(r[2], r[3]);
                            *(v2u*)((bf16*)(out + off - col0) + col0 + bj * 128 + n * 16) = w; } }
                asm volatile("" ::: "memory"); }
    }
};

struct SchedMoe {
    int G, c, ncol; const int* tileb; size_t b_exp_stride  , ldb  , lda  ; bool gather;
    DI bool next(int i, Unit& u) const {
        const int ntile = tileb[32]; const long L = (long)i * G + c; if (L >= (long)ntile * ncol) return false;
        const int rt = (int)(L / ncol), pn = (int)(L % ncol); const int e = tileb[64 + rt];
        u.pm = rt; u.pn = pn; u.grow = rt * 256; u.aoff = gather ? 0 : (size_t)rt * 256 * lda; u.boff = (size_t)e * b_exp_stride + (size_t)pn * 256 * ldb; return true;
    }
};
DI int moe_expert_of_tile(const int* tileb, int rt) { return tileb[64 + rt]; }
struct EpiSwiglu {
    static constexpr bool PERM = true;
    unsigned char* ACT; const float* b1; const int* tileb;
    DI void operator()(const f32x4 (&acc)[2][2][4][2], const Unit& u, int wr, int wc, int fr, int fq) const {
        const int e = moe_expert_of_tile(tileb, u.pm); const int cg = u.pn * 128 + wc * 32 + 8 * fq;
        const float* bp = b1 + (size_t)e * 2048 + cg;
        const f32x4 bg0 = *(const f32x4*)(bp), bg1 = *(const f32x4*)(bp + 4), bu0 = *(const f32x4*)(bp + 1024), bu1 = *(const f32x4*)(bp + 1028);
        unsigned char* base = ACT + (size_t)(u.pm * 256 + wr * 64 + fr) * 1024 + cg;
#pragma unroll
        for (int ai = 0; ai < 2; ++ai)
#pragma unroll
            for (int m = 0; m < 4; ++m) {
                f32x4 g0 = acc[ai][0][m][0] + bg0, g1 = acc[ai][0][m][1] + bg1, u0 = acc[ai][1][m][0] + bu0, u1 = acc[ai][1][m][1] + bu1;
#pragma unroll
                for (int j = 0; j < 4; ++j) {
                    const float ga = fminf(g0[j], 7.0f), gb = fminf(g1[j], 7.0f);
                    const float ua = fminf(fmaxf(u0[j], -7.0f), 7.0f), ub = fminf(fmaxf(u1[j], -7.0f), 7.0f);
                    g0[j] = 4.0f * ga * fast_sigmoid(1.702f * ga) * (ua + 1.0f); g1[j] = 4.0f * gb * fast_sigmoid(1.702f * gb) * (ub + 1.0f);
                }
                v2u w; w.x = pk4_fp8(g0[0], g0[1], g0[2], g0[3]); w.y = pk4_fp8(g1[0], g1[1], g1[2], g1[3]);
                __builtin_nontemporal_store(w, (v2u*)(base + (size_t)(ai * 128 + m * 16) * 1024));
                asm volatile("" ::: "memory");
            }
    }
};
struct EpiDown {
    static constexpr bool PERM = true;
    bf16* Y2; const float* b2; const int* tileb; const float* roww;
    DI void operator()(const f32x4 (&acc)[2][2][4][2], const Unit& u, int wr, int wc, int fr, int fq) const {
        const int e = moe_expert_of_tile(tileb, u.pm); const int c0 = u.pn * 256 + wc * 32 + 8 * fq;
        f32x4 bv[2][2];
#pragma unroll
        for (int bj = 0; bj < 2; ++bj)
#pragma unroll
            for (int n = 0; n < 2; ++n) bv[bj][n] = *(const f32x4*)(b2 + (size_t)e * 1024 + c0 + bj * 128 + 4 * n);
        float wq[2][4];
#pragma unroll
        for (int ai = 0; ai < 2; ++ai)
#pragma unroll
            for (int m = 0; m < 4; ++m) wq[ai][m] = roww[u.pm * 256 + ai * 128 + wr * 64 + m * 16 + fr];
        bf16* base = Y2 + (size_t)(u.pm * 256 + wr * 64 + fr) * 1024 + c0;
#pragma unroll
        for (int ai = 0; ai < 2; ++ai)
#pragma unroll
            for (int m = 0; m < 4; ++m) { const float w = wq[ai][m];
#pragma unroll
                for (int bj = 0; bj < 2; ++bj) __builtin_nontemporal_store(pack8((acc[ai][bj][m][0] + bv[bj][0]) * w, (acc[ai][bj][m][1] + bv[bj][1]) * w), (v4u*)(base + (size_t)(ai * 128 + m * 16) * 1024 + bj * 128));
            }
    }
};
}

namespace att {
constexpr int D = 128, NW = 8, QBLK = 32, KVBLK = 64;
constexpr float SCALE = 0.088388347648318440f;
constexpr float THR = 1.9f;
constexpr float PSH = 6.f;
constexpr float QSC = SCALE * 1.4426950408889634f;
constexpr float THR2 = THR * 1.4426950408889634f;
constexpr float VSC = 8.f;
constexpr int LDQ = 1024, LDK = 256, LDO = 1024;
constexpr size_t SHM_V = KVBLK * D, SHM_K = KVBLK * D, SLOT = SHM_K + SHM_V, SHM_ATTN = 8 * SLOT;
typedef int v8i32 __attribute__((ext_vector_type(8)));
#define KSWZ(row, colB) ((row) * 128 + ((colB) ^ ((((row) >> 1) & 7) << 4)))
#define SBAR() __builtin_amdgcn_sched_barrier(0)
DI int crow(int r, int hi) { return (r & 3) + 8 * (r >> 2) + 4 * hi; }
DI unsigned cvtpk(float lo, float hi) { unsigned r; asm volatile("v_cvt_pk_bf16_f32 %0, %1, %2" : "=v"(r) : "v"(lo), "v"(hi)); return r; }

DI void head_tile0(f32x16& p0, f32x16& p1, f32x16& nm, const char* Ks, const v8i32* qf, int r32, int hi) {
  p0 = f32x16{}; p1 = f32x16{};
#pragma unroll
  for (int c = 0; c < 2; ++c) { const int cb = c * 64 + hi * 32;
    const v4u a0 = *reinterpret_cast<const v4u*>(Ks + KSWZ(r32, cb)), a1 = *reinterpret_cast<const v4u*>(Ks + KSWZ(r32, cb + 16));
    const v4u b0 = *reinterpret_cast<const v4u*>(Ks + KSWZ(32 + r32, cb)), b1 = *reinterpret_cast<const v4u*>(Ks + KSWZ(32 + r32, cb + 16));
    const v8i32 ka = {(int)a0.x, (int)a0.y, (int)a0.z, (int)a0.w, (int)a1.x, (int)a1.y, (int)a1.z, (int)a1.w};
    const v8i32 kb = {(int)b0.x, (int)b0.y, (int)b0.z, (int)b0.w, (int)b1.x, (int)b1.y, (int)b1.z, (int)b1.w};
    p0 = __builtin_amdgcn_mfma_scale_f32_32x32x64_f8f6f4(ka, qf[c], p0, 0, 0, 0, 0, 0, 0);
    p1 = __builtin_amdgcn_mfma_scale_f32_32x32x64_f8f6f4(kb, qf[c], p1, 0, 0, 0, 0, 0, 0); }
  float pmax = p0[0]; for (int r = 1; r < 16; ++r) pmax = fmaxf(pmax, p0[r]); for (int r = 0; r < 16; ++r) pmax = fmaxf(pmax, p1[r]);
  { auto rr = __builtin_amdgcn_permlane32_swap(__float_as_uint(pmax), __float_as_uint(pmax), false, false);
    pmax = fmaxf(__uint_as_float(rr[0]), __uint_as_float(rr[1])); }
  const float nmv = PSH - pmax;
  for (int r = 0; r < 16; ++r) { nm[r] = nmv; p0[r] = __builtin_amdgcn_exp2f(p0[r] + nmv); p1[r] += nmv; }
}
DI void finishSM(f32x16& p0, f32x16& p1, v8i32& pb) {
  for (int r = 0; r < 16; ++r) p1[r] = __builtin_amdgcn_exp2f(p1[r]);
#pragma unroll
  for (int w = 0; w < 4; ++w) { pb[w] = (int)pk4_fp8(p0[4 * w], p0[4 * w + 1], p0[4 * w + 2], p0[4 * w + 3]); pb[4 + w] = (int)pk4_fp8(p1[4 * w], p1[4 * w + 1], p1[4 * w + 2], p1[4 * w + 3]); }
}
DI void pv8(f32x16* o, const char* Vs, int va, const v8i32& pb) {
#pragma unroll
  for (int db = 0; db < 4; ++db) {
    const v4u x0 = *reinterpret_cast<const v4u*>(Vs + db * 2048 + va), x1 = *reinterpret_cast<const v4u*>(Vs + db * 2048 + (va ^ 16));
    const v8i32 vt = {(int)x0.x, (int)x0.y, (int)x0.z, (int)x0.w, (int)x1.x, (int)x1.y, (int)x1.z, (int)x1.w};
    o[db] = __builtin_amdgcn_mfma_scale_f32_32x32x64_f8f6f4(vt, pb, o[db], 0, 0, 0, 0, 0, 0); }
}

DI v8i32 krd(const char* Ks, int row, int cb) { const v4u a = *reinterpret_cast<const v4u*>(Ks + KSWZ(row, cb)), b = *reinterpret_cast<const v4u*>(Ks + KSWZ(row, cb + 16));
  return v8i32{(int)a.x, (int)a.y, (int)a.z, (int)a.w, (int)b.x, (int)b.y, (int)b.z, (int)b.w}; }
DI v8i32 vrd(const char* Vs, int db, int va) { const v4u a = *reinterpret_cast<const v4u*>(Vs + db * 2048 + va), b = *reinterpret_cast<const v4u*>(Vs + db * 2048 + (va ^ 16));
  return v8i32{(int)a.x, (int)a.y, (int)a.z, (int)a.w, (int)b.x, (int)b.y, (int)b.z, (int)b.w}; }
#define MF8(a, b, c) __builtin_amdgcn_mfma_scale_f32_32x32x64_f8f6f4(a, b, c, 0, 0, 0, 0, 0, 0)
DI v8i32 mkones() { v8i32 o; for (int w = 0; w < 8; ++w) { int x_; asm volatile("v_mov_b32 %0, 0x38383838" : "=v"(x_)); o[w] = x_; } return o; }
#ifdef DIAG_ATT
#define ATT_ONES mkones()
#else
#define ATT_ONES ones
#endif
#define ANCH(x) asm volatile("" : "+v"(x))
#define MFS(a, b, c) __builtin_amdgcn_mfma_scale_f32_32x32x64_f8f6f4(a, b, c, 0, 0, 0, 0, 0, 0)
#define PKC(dst, P, w) do { int t_ = __builtin_amdgcn_cvt_pk_fp8_f32(P[4 * (w)], P[4 * (w) + 1], dst, false); dst = __builtin_amdgcn_cvt_pk_fp8_f32(P[4 * (w) + 2], P[4 * (w) + 3], t_, true); } while (0)
#define ATT_STEP(pC0, pC1, alC, pN0, pN1, alN, KB, VB) do {                                                                                            \
    SBAR(); const v8i32 k0_ = krd(KB, r32, hi * 32), k1_ = krd(KB, 32 + r32, hi * 32);                                                                  \
    SBAR(); pN0 = MFS(k0_, qf[0], nm);                                                                                                                  \
    SBAR(); for (int r = 0; r < 8; ++r) pC1[r] = __builtin_amdgcn_exp2f(pC1[r]);                                                                       \
    const v8i32 k2_ = krd(KB, r32, 64 + hi * 32), k3_ = krd(KB, 32 + r32, 64 + hi * 32); ANCH(pC1);                                                     \
    SBAR(); pN1 = MFS(k1_, qf[0], nm);                                                                                                                  \
    SBAR(); for (int r = 8; r < 16; ++r) pC1[r] = __builtin_amdgcn_exp2f(pC1[r]); ANCH(pC1);                                                           \
    SBAR(); pN0 = MFS(k2_, qf[1], pN0);                                                                                                                 \
    SBAR(); PKC(pb[0], pC0, 0); PKC(pb[1], pC0, 1); PKC(pb[2], pC0, 2); PKC(pb[3], pC0, 3);                                                                     \
    SBAR(); pN1 = MFS(k3_, qf[1], pN1);                                                                                                                 \
    SBAR(); PKC(pb[4], pC1, 0); PKC(pb[5], pC1, 1); PKC(pb[6], pC1, 2); PKC(pb[7], pC1, 3);                                                                     \
    const v8i32 v0_ = vrd(VB, 0, va), v1_ = vrd(VB, 1, va);                                                                                             \
    SBAR(); o[0] = MF8(v0_, pb, o[0]);                                                                                                                  \
    SBAR(); pC0 = MF8(ATT_ONES, pb, f32x16{});     \
    SBAR(); float pm_ = fmaxf(pN0[0], pN1[0]); for (int r = 1; r < 16; ++r) pm_ = fmaxf(fmaxf(pm_, pN0[r]), pN1[r]);                                   \
    { auto rr = __builtin_amdgcn_permlane32_swap(__float_as_uint(pm_), __float_as_uint(pm_), false, false); pm_ = fmaxf(__uint_as_float(rr[0]), __uint_as_float(rr[1])); } \
    const v8i32 v2_ = vrd(VB, 2, va), v3_ = vrd(VB, 3, va); alN = 1.f;                                                                                  \
    if (__builtin_expect(!__all(pm_ - PSH <= THR2), 0)) { const float dl_ = fmaxf(pm_ - PSH, 0.f); alN = __builtin_amdgcn_exp2f(-dl_);                  \
      for (int r = 0; r < 16; ++r) { pN0[r] -= dl_; pN1[r] -= dl_; nm[r] -= dl_; } }                                                                    \
    SBAR(); o[1] = MF8(v1_, pb, o[1]);                                                                                                                  \
    SBAR(); for (int r = 0; r < 8; ++r) pN0[r] = __builtin_amdgcn_exp2f(pN0[r]); ANCH(pN0);                                                            \
    SBAR(); o[2] = MF8(v2_, pb, o[2]);                                                                                                                  \
    SBAR(); for (int r = 8; r < 16; ++r) pN0[r] = __builtin_amdgcn_exp2f(pN0[r]); ANCH(pN0);                                                           \
    SBAR(); o[3] = MF8(v3_, pb, o[3]);                                                                                                                  \
    SBAR(); l_reg = l_reg * alC + pC0[0]; ANCH(l_reg);                                                                                                  \
    SBAR(); } while (0)

DI void attn_dense_body(const bf16* Qb, const unsigned char* __restrict__ K8h, const unsigned char* __restrict__ V8h, bf16* Ob, unsigned char* O8b, int seq, LAS unsigned char* ldsl,
                        int tpos0, const float* __restrict__ qn, const float* __restrict__ cosa, const float* __restrict__ sina) {
  const int tid = opaque_tid(), wid = tid >> 6, lane = tid & 63, r32 = lane & 31, hi = lane >> 5;
  const char* lds = (const char*)ldsl;
  f32x16 o[4] = {}; f32x16 nm; v8i32 qf[2]; float l_reg = 0.f;
  v8i32 ones;
#pragma unroll
  for (int w = 0; w < 8; ++w) { int x_; asm volatile("v_mov_b32 %0, 0x38383838" : "=v"(x_)); ones[w] = x_; }
  char* const ldsw = (char*)ldsl;
  v4u st_k, st_v;
#define SLOAD(t_) do { st_k = *reinterpret_cast<const v4u*>(K8h + (long)(t_) * 8192 + tid * 16); st_v = *reinterpret_cast<const v4u*>(V8h + (long)(t_) * 8192 + tid * 16); } while (0)
#define SWRITE(t_) do { *reinterpret_cast<v4u*>(ldsw + ((t_) & 7) * (int)SLOT + tid * 16) = st_k; *reinterpret_cast<v4u*>(ldsw + ((t_) & 7) * (int)SLOT + (int)SHM_K + tid * 16) = st_v; } while (0)
  const v4u pk0_ = *reinterpret_cast<const v4u*>(K8h + tid * 16), pv0_ = *reinterpret_cast<const v4u*>(V8h + tid * 16);
  const v4u pk1_ = *reinterpret_cast<const v4u*>(K8h + 8192 + tid * 16), pv1_ = *reinterpret_cast<const v4u*>(V8h + 8192 + tid * 16);
  SLOAD(2);
  {
    const bf16* Qw = Qb + (long)(wid * QBLK + r32) * LDQ;
    float ss = 0.f;
#pragma unroll
    for (int d0 = 0; d0 < 8; ++d0) { const v4u w = *reinterpret_cast<const v4u*>(Qw + d0 * 16 + hi * 8);
      const float a0 = bf_lo(w.x), a1 = bf_hi(w.x), a2 = bf_lo(w.y), a3 = bf_hi(w.y), a4 = bf_lo(w.z), a5 = bf_hi(w.z), a6 = bf_lo(w.w), a7 = bf_hi(w.w);
      ss += (a0 * a0 + a1 * a1) + (a2 * a2 + a3 * a3) + (a4 * a4 + a5 * a5) + (a6 * a6 + a7 * a7); }
    { auto rr = __builtin_amdgcn_permlane32_swap(__float_as_uint(ss), __float_as_uint(ss), false, false); ss = __uint_as_float(rr[0]) + __uint_as_float(rr[1]); }
    const float rstd = 1.0f / sqrtf(ss * (1.0f / 128.0f) + EPS);
    const int t = tpos0 + wid * QBLK + r32;
#pragma unroll
    for (int a = 0; a < 2; ++a) { const int pos = a ? (t & 63) : (t >> 6);
#pragma unroll
      for (int g = 0; g < 4; ++g) {
        const v4u wa = *reinterpret_cast<const v4u*>(Qw + 64 * a + 8 * g), wb = *reinterpret_cast<const v4u*>(Qw + 64 * a + 32 + 8 * g);
        float x1[8] = {bf_lo(wa.x), bf_hi(wa.x), bf_lo(wa.y), bf_hi(wa.y), bf_lo(wa.z), bf_hi(wa.z), bf_lo(wa.w), bf_hi(wa.w)};
        float x2[8] = {bf_lo(wb.x), bf_hi(wb.x), bf_lo(wb.y), bf_hi(wb.y), bf_lo(wb.z), bf_hi(wb.z), bf_lo(wb.w), bf_hi(wb.w)};
        float oo[8];
#pragma unroll
        for (int j = 0; j < 8; ++j) { const float g1 = qn[64 * a + 8 * g + j] * rstd, g2 = qn[64 * a + 32 + 8 * g + j] * rstd; const float cs = cosa[pos * 32 + 8 * g + j], sn = sina[pos * 32 + 8 * g + j];
          const float y1 = x1[j] * g1, y2 = x2[j] * g2; const float v = hi ? (y2 * cs + y1 * sn) : (y1 * cs - y2 * sn); oo[j] = __builtin_amdgcn_fmed3f(v * QSC, -448.f, 448.f); }
        qf[a][2 * g] = (int)pk4_fp8(oo[0], oo[1], oo[2], oo[3]); qf[a][2 * g + 1] = (int)pk4_fp8(oo[4], oo[5], oo[6], oo[7]); } }
  }
  const int va = r32 * 64 + (((2 * hi) ^ ((r32 >> 2) & 3)) << 4);
#define RESC(a) do { if (__any((a) < 1.f)) { for (int d = 0; d < 4; ++d) for (int r = 0; r < 16; ++r) o[d][r] *= (a); } } while (0)
#define KSLOT(t_) (lds + ((t_) & 7) * (int)SLOT)
#define VSLOT(t_) (lds + ((t_) & 7) * (int)SLOT + (int)SHM_K)
  f32x16 pA0, pA1, pB0, pB1; float alA = 1.f, alB; v8i32 pb = {0, 0, 0, 0, 0, 0, 0, 0}; const int NT = seq / KVBLK;
  *reinterpret_cast<v4u*>(ldsw + tid * 16) = pk0_; *reinterpret_cast<v4u*>(ldsw + (int)SHM_K + tid * 16) = pv0_;
  *reinterpret_cast<v4u*>(ldsw + (int)SLOT + tid * 16) = pk1_; *reinterpret_cast<v4u*>(ldsw + (int)SLOT + (int)SHM_K + tid * 16) = pv1_;
  SWRITE(2); __syncthreads();
  head_tile0(pA0, pA1, nm, KSLOT(0), qf, r32, hi);
  for (int t = 0; t + 2 < NT; t += 2) {
    if (t + 3 < NT) SLOAD(t + 3); RESC(alA);
    ATT_STEP(pA0, pA1, alA, pB0, pB1, alB, KSLOT(t + 1), VSLOT(t));
    if (t + 3 < NT) SWRITE(t + 3);
    if (t + 4 < NT) SLOAD(t + 4); RESC(alB);
    ATT_STEP(pB0, pB1, alB, pA0, pA1, alA, KSLOT(t + 2), VSLOT(t + 1));
    if (t + 4 < NT) SWRITE(t + 4); __syncthreads();
  }
  RESC(alA);
  ATT_STEP(pA0, pA1, alA, pB0, pB1, alB, KSLOT(NT - 1), VSLOT(NT - 2));
  RESC(alB);
  finishSM(pB0, pB1, pb); SBAR();
  pv8(o, VSLOT(NT - 1), va, pb); pB0 = MF8(ATT_ONES, pb, f32x16{}); l_reg = l_reg * alB + pB0[0];
  const float rl = __builtin_amdgcn_rcpf(l_reg) * (1.0f / VSC);
  const int tid2 = opaque_tid();
#ifdef DIAG_ATT
  bf16* Ow = Ob + (long)((tid2 >> 6) * QBLK + (tid2 & 31)) * LDO + 4 * ((tid2 >> 5) & 1);
#pragma unroll
  for (int db = 0; db < 4; ++db)
#pragma unroll
    for (int r4 = 0; r4 < 4; ++r4) { v2u w; w.x = cvtpk(o[db][4 * r4] * rl, o[db][4 * r4 + 1] * rl); w.y = cvtpk(o[db][4 * r4 + 2] * rl, o[db][4 * r4 + 3] * rl);
      *reinterpret_cast<v2u*>(Ow + 32 * db + 8 * r4) = w; }
#else
  unsigned char* Ow = O8b + (long)((tid2 >> 6) * QBLK + (tid2 & 31)) * LDO + 4 * ((tid2 >> 5) & 1);
  const float rl4 = rl * 4.0f;
#pragma unroll
  for (int db = 0; db < 4; ++db)
#pragma unroll
    for (int r4 = 0; r4 < 4; ++r4)
      *reinterpret_cast<unsigned*>(Ow + 32 * db + 8 * r4) = pk4_fp8(__builtin_amdgcn_fmed3f(o[db][4 * r4] * rl4, -448.f, 448.f), __builtin_amdgcn_fmed3f(o[db][4 * r4 + 1] * rl4, -448.f, 448.f),
                                                                  __builtin_amdgcn_fmed3f(o[db][4 * r4 + 2] * rl4, -448.f, 448.f), __builtin_amdgcn_fmed3f(o[db][4 * r4 + 3] * rl4, -448.f, 448.f));
  (void)Ob;
#endif
  __syncthreads();
#undef SLOAD
#undef SWRITE
#undef KSLOT
#undef VSLOT
#undef RESC
}
#undef ATT_STEP
#undef MFS
#undef PKC
#undef ANCH
#undef MF8
#undef KSWZ
}
namespace ret {
constexpr int C = 128;
constexpr int KP = 1088, KTILE = 16 * KP, VP = 2112;
constexpr int VIMG = 8 * VP;
constexpr int KT_OFF = 0, V_OFF = 4 * KTILE, ST_OFF = V_OFF + 2 * VIMG, P_OFF = ST_OFF + 2 * KTILE, RET_LDS = P_OFF + 10 * 2048;
DI int crow(int r, int hi) { return (r & 3) + 8 * (r >> 2) + 4 * hi; }
typedef short v4i16_t __attribute__((ext_vector_type(4)));
DI s16x4 vtr(unsigned addr) { return __builtin_bit_cast(s16x4, __builtin_amdgcn_ds_read_tr16_b64_v4i16((LAS v4i16_t*)addr)); }
DI bf16x8 cat8(s16x4 l, s16x4 h) { return (bf16x8){l[0], l[1], l[2], l[3], h[0], h[1], h[2], h[3]}; }
DI bf16x8 ldsr(unsigned addr) { return *(const LAS bf16x8*)(uintptr_t)addr; }
#define RPK4(P, BASE, OUT) do { unsigned a0 = cvt_pk_bf16(P[BASE + 0], P[BASE + 1]), a1 = cvt_pk_bf16(P[BASE + 2], P[BASE + 3]);   \
    unsigned b0 = cvt_pk_bf16(P[BASE + 4], P[BASE + 5]), b1 = cvt_pk_bf16(P[BASE + 6], P[BASE + 7]);                              \
    auto r0 = __builtin_amdgcn_permlane32_swap(a0, b0, false, false); auto r1 = __builtin_amdgcn_permlane32_swap(a1, b1, false, false); \
    v4u w = {r0[0], r1[0], r0[1], r1[1]}; OUT = *reinterpret_cast<bf16x8*>(&w); } while (0)
#define RMFMA(a, b, c) __builtin_amdgcn_mfma_f32_32x32x16_bf16((a), (b), (c), 0, 0, 0)
#define RPRIO(x) __builtin_amdgcn_s_setprio(x)
#define RBAR() do { asm volatile("s_waitcnt lgkmcnt(0)" ::: "memory"); __builtin_amdgcn_s_barrier(); asm volatile("" ::: "memory"); } while (0)

DI void ret_unit(LAS unsigned char* lds, const bf16* __restrict__ QR, const bf16* __restrict__ KR, const bf16* __restrict__ VR, bf16* __restrict__ O,
                 const int rowbase, const int h, const int fwd, const int sl, const float lg) {
    const int tid = opaque_tid(), wid = __builtin_amdgcn_readfirstlane(tid >> 6), lane = tid & 63, r = lane & 31, hi = lane >> 5;
    const int eb = wid >> 2, qb = eb ? 7 - wid : wid, dq = wid & 3;
    const unsigned lbase = (unsigned)(uintptr_t)lds;
    const float lg2 = lg * 1.4426950408889634f;
    const float dC = __builtin_amdgcn_exp2f(lg2 * (float)C);
    const int iq = 32 * qb + r;
    const int kb_lo = fwd ? 0 : qb, ntile = fwd ? qb + 1 : 4 - qb, hup = (ntile + 1) >> 1, t0 = eb ? hup : 0, t1 = eb ? ntile : hup;
    const int vk0 = tid >> 3, vk1 = 64 + (tid >> 3), vch = tid & 7;
    const unsigned vdst0 = lbase + V_OFF + vch * VP + vk0 * 16, vdst1 = lbase + V_OFF + vch * VP + vk1 * 16;
    const bf16* vsrc = VR + (size_t)h * 512 + sl * 64 + vch * 8;
    const bf16* ksrc = KR + ((size_t)((wid >> 2) * 4 + h) * 2 + ((wid >> 1) & 1)) * 8192 + ((wid & 1) * 8 * 64 + lane) * 8;
    const int trblk = (lane >> 4) & 1, trq = (lane & 15) >> 2, trp = lane & 3;
    const unsigned rd_row = lbase + (unsigned)(hi * KP + r * 16);
    const unsigned tr_k = lbase + KT_OFF + (unsigned)((2 * trblk + (trp >> 1)) * KP + (8 * hi + trq) * 16 + 8 * (trp & 1));
    const unsigned tr_v = lbase + V_OFF + (unsigned)((2 * trblk + (trp >> 1)) * VP + (8 * hi + trq) * 16 + 8 * (trp & 1)) + 4 * eb * VP;
    const unsigned p_my = lbase + P_OFF + lane * 16;
    const int pq = fwd ? qb : 3 - qb; const int pslot0 = pq * (pq + 1) / 2;
    f32x16 st0 = {}, st1 = {};
    bf16x8 q[16];
    auto chunk_row = [&](int n) -> int {
        if (fwd) return n < 2 ? rowbase + 128 * n : rowbase + 256 + 128 * (n - 2);
        return n < 2 ? rowbase + 128 * (1 - n) : rowbase + 256 + 128 * (65 - n);
    };
#define ISSUE_K(n) do { const bf16* kp = ksrc + (size_t)(chunk_row(n) >> 6) * 65536; _Pragma("unroll") for (int j = 0; j < 8; ++j) \
        __builtin_amdgcn_global_load_lds((const unsigned*)(kp + j * 512), (LAS unsigned*)(lds + KT_OFF + (wid >> 1) * KTILE + ((wid & 1) * 8 + j) * KP), 16, 0, 0); } while (0)
#define LOAD_V(n, a, b) do { const bf16* vp = vsrc + (size_t)chunk_row(n) * 2048; a = *(const v4u*)(vp + (size_t)vk0 * 2048); b = *(const v4u*)(vp + (size_t)vk1 * 2048); } while (0)
#define WRITE_V(a, b, vbo_) do { v4u t0_, t1_; const float vw0 = __builtin_amdgcn_exp2f(lg2 * (float)(fwd ? (C - 1 - vk0) : vk0)), vw1 = __builtin_amdgcn_exp2f(lg2 * (float)(fwd ? (C - 1 - vk1) : vk1));   \
        t0_.x = cvt_pk_bf16(bf_lo(a.x) * vw0, bf_hi(a.x) * vw0); t0_.y = cvt_pk_bf16(bf_lo(a.y) * vw0, bf_hi(a.y) * vw0); t0_.z = cvt_pk_bf16(bf_lo(a.z) * vw0, bf_hi(a.z) * vw0); t0_.w = cvt_pk_bf16(bf_lo(a.w) * vw0, bf_hi(a.w) * vw0); \
        t1_.x = cvt_pk_bf16(bf_lo(b.x) * vw1, bf_hi(b.x) * vw1); t1_.y = cvt_pk_bf16(bf_lo(b.y) * vw1, bf_hi(b.y) * vw1); t1_.z = cvt_pk_bf16(bf_lo(b.z) * vw1, bf_hi(b.z) * vw1); t1_.w = cvt_pk_bf16(bf_lo(b.w) * vw1, bf_hi(b.w) * vw1); \
        *(LAS v4u*)(uintptr_t)(vdst0 + vbo_) = t0_; *(LAS v4u*)(uintptr_t)(vdst1 + vbo_) = t1_; } while (0)
    { unsigned z_; asm volatile("v_mov_b32 %0, 0" : "=v"(z_));
      for (int i = tid; i < 2 * KTILE / 16; i += 512) *(LAS v4u*)(lds + ST_OFF + i * 16) = (v4u){z_, z_, z_, z_}; }
    v4u va, vb;
    ISSUE_K(0);
    LOAD_V(0, va, vb);
    { const bf16* qp = QR + (size_t)(((chunk_row(2) >> 5) + qb) * 4 + h) * 8192 + lane * 8;
#pragma unroll
      for (int s = 0; s < 16; ++s) q[s] = *(const bf16x8*)(qp + s * 512); }
    WRITE_V(va, vb, 0u);
    LOAD_V(1, va, vb);
#pragma unroll 1
    for (int n = 0; n < 66; ++n) {
        if (n >= 3) asm volatile("s_waitcnt vmcnt(32)" ::: "memory"); else asm volatile("s_waitcnt vmcnt(0)" ::: "memory");
        RBAR();
        const unsigned vb_cur = (unsigned)(n & 1) * VIMG, vb_nxt = (unsigned)((n + 1) & 1) * VIMG;
        const bool lat = n >= 2;
        if (n > 0) {
#pragma unroll
            for (int t = 0; t < 2; ++t) { const int db = 2 * dq + t; const unsigned img = lbase + ST_OFF + (db >> 2) * KTILE + 4 * (db & 3) * KP + (32 * eb + r) * 16 + 8 * hi;
#pragma unroll
                for (int g = 0; g < 4; ++g) { v2u w; const f32x16& sref = t ? st1 : st0; w.x = cvt_pk_bf16(sref[4 * g], sref[4 * g + 1]); w.y = cvt_pk_bf16(sref[4 * g + 2], sref[4 * g + 3]);
                    *(LAS v2u*)(uintptr_t)(img + g * KP) = w; } }
        }
#pragma unroll
        for (int g = 0; g < 16; ++g) { st0[g] *= dC; st1[g] *= dC; }
        {
            const unsigned kb0 = tr_k + (dq >> 1) * KTILE + 8 * (dq & 1) * KP;
            s16x4 v0 = vtr(tr_v + vb_cur), v1 = vtr(tr_v + vb_cur + 64), a0 = vtr(kb0), a1 = vtr(kb0 + 64), b0 = vtr(kb0 + 4 * KP), b1 = vtr(kb0 + 4 * KP + 64);
#pragma unroll
            for (int g = 0; g < 8; ++g) {
                const bf16x8 vf = cat8(v0, v1), kt0 = cat8(a0, a1), kt1 = cat8(b0, b1);
                if (g < 7) { const int g1 = g + 1; const unsigned ka = kb0 + (g1 >> 2) * 2 * KTILE + (32 * ((g1 >> 1) & 1) + 16 * (g1 & 1)) * 16, vaq = tr_v + vb_cur + g1 * 256;
                    v0 = vtr(vaq); v1 = vtr(vaq + 64); a0 = vtr(ka); a1 = vtr(ka + 64); b0 = vtr(ka + 4 * KP); b1 = vtr(ka + 4 * KP + 64); }
                RPRIO(1); st0 = RMFMA(kt0, vf, st0); st1 = RMFMA(kt1, vf, st1); RPRIO(0);
            }
        }
        if (lat) {
#pragma unroll 1
            for (int ti = t0; ti < t1; ++ti) {
                const int kb = kb_lo + ti;
                const unsigned kbase = rd_row + KT_OFF + (kb >> 1) * 2 * KTILE + (kb & 1) * 512;
                f32x16 pt = {};
                bf16x8 c0 = ldsr(kbase), c1 = ldsr(kbase + 2 * KP), c2 = ldsr(kbase + 4 * KP), c3 = ldsr(kbase + 6 * KP);
                __builtin_amdgcn_sched_barrier(0);
#pragma unroll
                for (int sg = 0; sg < 4; ++sg) {
                    bf16x8 n0, n1, n2, n3;
                    if (sg < 3) { const unsigned nb = kbase + ((sg + 1) >> 1) * KTILE + ((sg + 1) & 1) * 8 * KP; n0 = ldsr(nb); n1 = ldsr(nb + 2 * KP); n2 = ldsr(nb + 4 * KP); n3 = ldsr(nb + 6 * KP); }
                    __builtin_amdgcn_sched_barrier(0);
                    RPRIO(1); pt = RMFMA(c0, q[4 * sg], pt); pt = RMFMA(c1, q[4 * sg + 1], pt); pt = RMFMA(c2, q[4 * sg + 2], pt); pt = RMFMA(c3, q[4 * sg + 3], pt); RPRIO(0);
                    __builtin_amdgcn_sched_barrier(0);
                    if (sg < 3) { c0 = n0; c1 = n1; c2 = n2; c3 = n3; }
                }
                const float rowscale = __builtin_amdgcn_exp2f(fwd ? lg2 * (float)(iq - (C - 1)) : -lg2 * (float)iq);
                if (kb == qb) {
#pragma unroll
                    for (int g = 0; g < 16; ++g) { const int j = 32 * kb + crow(g, hi); const bool keep = fwd ? (j <= iq) : (j > iq); pt[g] = keep ? pt[g] * rowscale : 0.f; }
                } else {
#pragma unroll
                    for (int g = 0; g < 16; ++g) pt[g] *= rowscale;
                }
                bf16x8 pa0, pa1; RPK4(pt, 0, pa0); RPK4(pt, 8, pa1);
                const unsigned ps = p_my + (pslot0 + (fwd ? kb : 3 - kb)) * 2048;
                *(LAS bf16x8*)(uintptr_t)ps = pa0; *(LAS bf16x8*)(uintptr_t)(ps + 1024) = pa1;
            }
        }
        RBAR();
        if (n + 1 < 66) WRITE_V(va, vb, vb_nxt);
        if (n + 2 < 66) LOAD_V(n + 2, va, vb);
        if (n + 1 < 66) ISSUE_K(n + 1);
        if (lat) {
            f32x16 opv = {};
            {
                unsigned ps = p_my + (pslot0 + (fwd ? kb_lo : 3 - kb_lo)) * 2048, vaq = tr_v + vb_cur + kb_lo * 512;
                bf16x8 pa0 = ldsr(ps), pa1 = ldsr(ps + 1024); s16x4 x0 = vtr(vaq), x1 = vtr(vaq + 64), x2 = vtr(vaq + 256), x3 = vtr(vaq + 320);
#pragma unroll 1
                for (int ti = 0; ti < ntile; ++ti) {
                    const bf16x8 ca0 = pa0, ca1 = pa1, vf0 = cat8(x0, x1), vf1 = cat8(x2, x3);
                    if (ti + 1 < ntile) { ps += fwd ? 2048 : -2048; vaq += 512; pa0 = ldsr(ps); pa1 = ldsr(ps + 1024); x0 = vtr(vaq); x1 = vtr(vaq + 64); x2 = vtr(vaq + 256); x3 = vtr(vaq + 320); }
                    RPRIO(1); opv = RMFMA(ca0, vf0, opv); opv = RMFMA(ca1, vf1, opv); RPRIO(0);
                }
            }
            f32x16 oqs = {};
            const bool more = n + 1 < 66;
            const bf16* qp = QR + (size_t)(((chunk_row(more ? n + 1 : n) >> 5) + qb) * 4 + h) * 8192 + lane * 8;
            const unsigned sbase = rd_row + ST_OFF + eb * 512;
            bf16x8 c0 = ldsr(sbase), c1 = ldsr(sbase + 2 * KP), c2 = ldsr(sbase + 4 * KP), c3 = ldsr(sbase + 6 * KP);
            __builtin_amdgcn_sched_barrier(0);
#pragma unroll
            for (int sg = 0; sg < 4; ++sg) {
                bf16x8 n0, n1, n2, n3;
                if (sg < 3) { const unsigned nb = sbase + ((sg + 1) >> 1) * KTILE + ((sg + 1) & 1) * 8 * KP; n0 = ldsr(nb); n1 = ldsr(nb + 2 * KP); n2 = ldsr(nb + 4 * KP); n3 = ldsr(nb + 6 * KP); }
                __builtin_amdgcn_sched_barrier(0);
                RPRIO(1); oqs = RMFMA(q[4 * sg], c0, oqs); oqs = RMFMA(q[4 * sg + 1], c1, oqs); oqs = RMFMA(q[4 * sg + 2], c2, oqs); oqs = RMFMA(q[4 * sg + 3], c3, oqs); RPRIO(0);
                __builtin_amdgcn_sched_barrier(0);
                if (sg < 3) { c0 = n0; c1 = n1; c2 = n2; c3 = n3; }
            }
#pragma unroll
            for (int s = 0; s < 16; ++s) q[s] = *(const bf16x8*)(qp + s * 512);
            asm volatile("" ::: "memory");
            bf16* op = O + (size_t)(chunk_row(n) + 32 * qb) * 2048 + h * 512 + sl * 64 + eb * 32 + r;
#pragma unroll
            for (int g = 0; g < 16; ++g) { const int i = 32 * qb + crow(g, hi);
                const float a = __builtin_amdgcn_exp2f(lg2 * (float)(fwd ? (i + 1) : (C - i)));
                op[(size_t)crow(g, hi) * 2048] = (bf16)(cvt_pk_bf16(opv[g] + a * oqs[g], 0.f) & 0xffffu); }
        }
    }
    asm volatile("s_waitcnt vmcnt(0)" ::: "memory");
    __syncthreads();
#undef ISSUE_K
#undef RPRIO
#undef LOAD_V
#undef WRITE_V
}
#undef RPK4
#undef RMFMA
#undef RBAR
}

struct Args { const float* in[22]; float* out; unsigned char* ws; };
typedef const __attribute__((address_space(4))) Args CArgs;
DI CArgs* kargs() { CArgs* p = (CArgs*)__builtin_amdgcn_kernarg_segment_ptr(); asm volatile("" : "+s"(p)); return p; }
struct Frame {
    LAS unsigned char* lds;
    volatile LAS unsigned* MISC;
};
DI int frame_vcu() { const int G = (int)gridDim.x, bx = (int)blockIdx.x; return (G % 8 == 0) ? (bx % 8) * (G / 8) + bx / 8 : bx; }
enum InIdx { I_X = 0, I_C, I_CTX, I_CCTX, I_NORM1, I_NORM2, I_WADA, I_BADA, I_WIN, I_DECF, I_DECB, I_QN, I_KN, I_WRO, I_WAO, I_WOUT, I_WR, I_BR, I_W1, I_B1, I_W2, I_B2 };

template <bool FP8> DI void transpose_task(const float* W, int K, int N, void* WTv, int k0, int n0, int drow0, int lane) {
    const int kr = lane >> 4, c4 = lane & 15;
    const float* src = W + (size_t)(k0 + 8 * kr) * N + n0 + 4 * c4;
    bf16* dst = (bf16*)WTv + (size_t)(drow0 + 4 * c4) * K + k0 + 8 * kr; unsigned char* dst8 = (unsigned char*)WTv + (size_t)(drow0 + 4 * c4) * K + k0 + 8 * kr;
#pragma unroll 2
    for (int g = 0; g < 8; ++g) {
        f32x4 v[8];
#pragma unroll
        for (int j = 0; j < 8; ++j) v[j] = *(const GAS f32x4*)(src + (size_t)(32 * g + j) * N);
#pragma unroll
        for (int cc = 0; cc < 4; ++cc) {
            if constexpr (FP8) { v2u o; o.x = pk4_fp8(16.f * v[0][cc], 16.f * v[1][cc], 16.f * v[2][cc], 16.f * v[3][cc]); o.y = pk4_fp8(16.f * v[4][cc], 16.f * v[5][cc], 16.f * v[6][cc], 16.f * v[7][cc]);     *(GAS v2u*)(dst8 + (size_t)cc * K + 32 * g) = o; }
            else { v4u o; o.x = cvt_pk_bf16(v[0][cc], v[1][cc]); o.y = cvt_pk_bf16(v[2][cc], v[3][cc]); o.z = cvt_pk_bf16(v[4][cc], v[5][cc]); o.w = cvt_pk_bf16(v[6][cc], v[7][cc]);
                *(GAS v4u*)(dst + (size_t)cc * K + 32 * g) = o; } }
    }
}
DI int win_dest_row(int n0) {
    if (n0 >= 2048) return n0;
    const int hb = n0 & ~255, c = n0 & 255, blk = c >> 6, within = c & 63;
    const int nb = blk == 1 ? 2 : (blk == 2 ? 1 : blk);
    return hb + nb * 64 + within;
}
DI int w1_dest_row(int n0) { const int up = n0 >= 1024, c = n0 & 1023; return 256 * (c >> 7) + 128 * up + (c & 127); }

DI void p0_prologue(Frame& F, CArgs* ap) {
    const int L_tid = opaque_tid(), L_lane = L_tid & 63, L_wave = __builtin_amdgcn_readfirstlane(L_tid >> 6);
    unsigned char* ws = ap->ws;
    const int gw = frame_vcu() * NWAVES + L_wave, NGW = ((int)gridDim.x) * NWAVES;
    if (blockIdx.x < 96) {
        LAS float* sc = (LAS float*)(F.lds);
        LAS float* red = (LAS float*)(F.lds + 40960);
        const float* cin = ap->in[I_C]; const float* cctx = ap->in[I_CCTX];
        for (int i = L_tid; i < 9 * 1024; i += 512) { const float v = i < 8192 ? cin[i] : cctx[i - 8192]; sc[i] = v * fast_sigmoid(v); }
        __syncthreads();
        const int n = blockIdx.x * 64 + L_lane; const float* wa = ap->in[I_WADA];
        float acc[9];
#pragma unroll
        for (int r = 0; r < 9; ++r) acc[r] = 0.f;
        for (int k = L_wave * 128; k < L_wave * 128 + 128; ++k) { const float w = wa[(size_t)k * 6144 + n];
#pragma unroll
            for (int r = 0; r < 9; ++r) acc[r] += sc[r * 1024 + k] * w; }
#pragma unroll
        for (int r = 0; r < 9; ++r) red[(L_wave * 9 + r) * 64 + L_lane] = acc[r];
        __syncthreads();
        float* mod = (float*)(ws + WS_MOD);
        for (int i = L_tid; i < 9 * 64; i += 512) { const int r = i >> 6, l = i & 63; float s = ap->in[I_BADA][blockIdx.x * 64 + l];
#pragma unroll
            for (int w = 0; w < 8; ++w) s += red[(w * 9 + r) * 64 + l];
            mod[(size_t)r * 6144 + blockIdx.x * 64 + l] = s; }
        __syncthreads();
    }
    if (blockIdx.x == ((int)gridDim.x) - 1) {
        float* cosr = (float*)(ws + WS_COSR); float* sinr = (float*)(ws + WS_SINR); float* cosa = (float*)(ws + WS_COSA); float* sina = (float*)(ws + WS_SINA);
        for (int i = L_tid; i < 128 * 64; i += 512) { const int pos = i >> 6, f = i & 63; const float inv = powf(10000.0f, -(float)f / 64.0f); const float ang = (float)pos * inv; cosr[i] = cosf(ang); sinr[i] = sinf(ang); }
        for (int i = L_tid; i < 128 * 32; i += 512) { const int pos = i >> 5, f = i & 31; const float inv = powf(10000.0f, -(float)f / 32.0f); const float ang = (float)pos * inv; cosa[i] = cosf(ang); sina[i] = sinf(ang); }
    }
    constexpr int T_IN = (INW / 64) * 4, T_RO = 16 * 8, T_AO = 16 * 4, T_OUT = 16 * 4, T_E1 = 32 * 4, T_E2 = 16 * 4;
    constexpr int NTASK = T_IN + T_RO + T_AO + T_OUT + NEXP * T_E1 + NEXP * T_E2;
    for (int it = gw; it < NTASK; it += NGW) {
        int r = it;
        if (r < T_IN) { const int nb = r >> 2, kq = r & 3; transpose_task<true>(ap->in[I_WIN], 1024, INW, (unsigned char*)(ws + WS_WIN), 256 * kq, 64 * nb, win_dest_row(64 * nb), L_lane); continue; } r -= T_IN;
        if (r < T_RO) { const int nb = r >> 3, kq = r & 7; transpose_task<true>(ap->in[I_WRO], 2048, 1024, (unsigned char*)(ws + WS_WRO), 256 * kq, 64 * nb, 64 * nb, L_lane); continue; } r -= T_RO;
        if (r < T_AO) { const int nb = r >> 2, kq = r & 3; transpose_task<true>(ap->in[I_WAO], 1024, 1024, (unsigned char*)(ws + WS_WAO), 256 * kq, 64 * nb, 64 * nb, L_lane); continue; } r -= T_AO;
        if (r < T_OUT) { const int nb = r >> 2, kq = r & 3; transpose_task<true>(ap->in[I_WOUT], 1024, 1024, (unsigned char*)(ws + WS_WOUT), 256 * kq, 64 * nb, 64 * nb, L_lane); continue; } r -= T_OUT;
        if (r < NEXP * T_E1) { const int e = r / T_E1, q = r % T_E1, nb = q >> 2, kq = q & 3;
            transpose_task<true>(ap->in[I_W1] + (size_t)e * 1024 * 2048, 1024, 2048, (unsigned char*)(ws + WS_W1) + (size_t)e * 2048 * 1024, 256 * kq, 64 * nb, w1_dest_row(64 * nb), L_lane); continue; } r -= NEXP * T_E1;
        { const int e = r / T_E2, q = r % T_E2, nb = q >> 2, kq = q & 3;
            transpose_task<true>(ap->in[I_W2] + (size_t)e * 1024 * 1024, 1024, 1024, (unsigned char*)(ws + WS_W2) + (size_t)e * 1024 * 1024, 256 * kq, 64 * nb, 64 * nb, L_lane); }
    }
}

DI void p_modulate(Frame& F, CArgs* ap) {
    const int L_tid = opaque_tid(), L_lane = L_tid & 63, L_wave = __builtin_amdgcn_readfirstlane(L_tid >> 6);
    const unsigned char* ws = ap->ws; const float* mod = (const float*)(ws + WS_MOD); unsigned char* H1 = ap->ws + WS_H1;
    const int gw = frame_vcu() * NWAVES + L_wave, NGW = ((int)gridDim.x) * NWAVES;
    const int per = (MROWS + NGW - 1) / NGW; const int r0 = gw * per, r1 = (r0 + per) < MROWS ? (r0 + per) : MROWS;
    int cur = -1; f32x4 pa[4], pb[4];
    for (int rowb = r0; rowb < r1; rowb += 3) {
        f32x4 v[3][4];
#pragma unroll
        for (int q = 0; q < 3; ++q) { const int row = (rowb + q) < r1 ? (rowb + q) : (r1 - 1); const int b = row / LT, p = row - b * LT;
            const float* src = p < LCTX ? ap->in[I_CTX] + ((size_t)b * LCTX + p) * DM : ap->in[I_X] + ((size_t)b * SEQ + (p - LCTX)) * DM;
#pragma unroll
            for (int j = 0; j < 4; ++j) v[q][j] = *((const GAS f32x4*)src + 64 * j + L_lane); }
#pragma unroll
        for (int q = 0; q < 3; ++q) { const int row = rowb + q; if (row < r1) {
            const int b = row / LT, p = row - b * LT; const int id = p < LCTX ? 8 : b;
            if (id != cur) { cur = id;
#pragma unroll
                for (int j = 0; j < 4; ++j) { const int k = 256 * j + 4 * L_lane; const f32x4 g = *(const f32x4*)(ap->in[I_NORM1] + k), sh = *(const f32x4*)(mod + (size_t)id * 6144 + k), sc = *(const f32x4*)(mod + (size_t)id * 6144 + 1024 + k);
                    pa[j] = g * (sc + 1.0f); pb[j] = sh; } }
            float s = 0.f;
#pragma unroll
            for (int j = 0; j < 4; ++j) s += (v[q][j].x * v[q][j].x + v[q][j].y * v[q][j].y) + (v[q][j].z * v[q][j].z + v[q][j].w * v[q][j].w);
            const float rstd = 1.0f / sqrtf(wave_sum(s) * (1.0f / DM) + EPS);
            GAS unsigned* o = (GAS unsigned*)(H1 + (size_t)row * DM) + L_lane;
#pragma unroll
            for (int j = 0; j < 4; ++j) { const f32x4 y = (v[q][j] * rstd * pa[j] + pb[j]) * 4.0f;
                o[64 * j] = pk4_fp8(__builtin_amdgcn_fmed3f(y.x, -448.f, 448.f), __builtin_amdgcn_fmed3f(y.y, -448.f, 448.f), __builtin_amdgcn_fmed3f(y.z, -448.f, 448.f), __builtin_amdgcn_fmed3f(y.w, -448.f, 448.f)); } } }
    }
}

DI void p_ar(Frame& F, CArgs* ap) {
    const int L_tid = opaque_tid(), L_lane = L_tid & 63, L_wave = __builtin_amdgcn_readfirstlane(L_tid >> 6);
    unsigned char* ws = ap->ws; const int gw = frame_vcu() * NWAVES + L_wave, NGW = ((int)gridDim.x) * NWAVES;
    bf16* GR = (bf16*)(ws + WS_GR); const bf16* OF = (const bf16*)(ws + WS_OF); const bf16* OB = (const bf16*)(ws + WS_OB);
    for (int i = gw; i < NBH * SEQ; i += NGW) {
        const int row = (i >> 13) * LT + LCTX + (i & 8191);
        v4u qa[4], qb[4], qg[4];
#pragma unroll
        for (int hh = 0; hh < 4; ++hh) { const size_t off = (size_t)row * 2048 + hh * 512 + 8 * L_lane; qa[hh] = *(const v4u*)(OF + off); qb[hh] = *(const v4u*)(OB + off); qg[hh] = *(const v4u*)(GR + off); }
#pragma unroll
        for (int hh = 0; hh < 4; ++hh) {
            f32x4 a0, a1, b0, b1, g0, g1; pg8::unpack8(qa[hh], a0, a1); pg8::unpack8(qb[hh], b0, b1); pg8::unpack8(qg[hh], g0, g1);
            a0 += b0; a1 += b1;
            float s = (a0.x * a0.x + a0.y * a0.y) + (a0.z * a0.z + a0.w * a0.w) + (a1.x * a1.x + a1.y * a1.y) + (a1.z * a1.z + a1.w * a1.w);
            const float rstd = 4.0f / sqrtf(wave_sum(s) * (1.0f / 512.0f) + EPS);
            const f32x4 y0 = a0 * g0 * rstd, y1 = a1 * g1 * rstd; v2u w;
#define AQ(v) __builtin_amdgcn_fmed3f((v), -448.f, 448.f)
            w.x = pk4_fp8(AQ(y0.x), AQ(y0.y), AQ(y0.z), AQ(y0.w)); w.y = pk4_fp8(AQ(y1.x), AQ(y1.y), AQ(y1.z), AQ(y1.w));
#undef AQ
            *(v2u*)((unsigned char*)GR + (size_t)row * 4096 + hh * 512 + 8 * L_lane) = w;
        }
    }
}
DI void p_knorm(Frame& F, CArgs* ap) {
    const int L_tid = opaque_tid(), L_lane = L_tid & 63, L_wave = __builtin_amdgcn_readfirstlane(L_tid >> 6);
    unsigned char* ws = ap->ws; const int gw = frame_vcu() * NWAVES + L_wave, NGW = ((int)gridDim.x) * NWAVES;
    const bf16* KA = (const bf16*)(ws + WS_KA); unsigned char* KA8 = ws + WS_KA8; const float* kn = ap->in[I_KN]; const float* cosa = (const float*)(ws + WS_COSA); const float* sina = (const float*)(ws + WS_SINA);
    const int d = (4 * L_lane) & 127;
    const f32x4 gk = *(const f32x4*)(kn + d);
    for (int row = gw; row < MH; row += NGW) {
        const int p = row % LT; const GAS v2u* ptr = (const GAS v2u*)(KA + (size_t)row * 256) + L_lane;
        const v2u w = *ptr; f32x4 v = {bf_lo(w.x), bf_hi(w.x), bf_lo(w.y), bf_hi(w.y)};
        float s = (v.x * v.x + v.y * v.y) + (v.z * v.z + v.w * v.w);
        s += lane_xor<1>(s); s += lane_xor<2>(s); s += lane_xor<4>(s); s += lane_xor<8>(s); s += lane_xor<16>(s);
        v = v * (1.0f / sqrtf(s * (1.0f / 128.0f) + EPS)) * gk;
        if (p >= LCTX) {
            const int t = p - LCTX, axis = (d >> 6) & 1, half = (d >> 5) & 1, f = d & 31, pos = axis ? (t & 63) : (t >> 6);
            const f32x4 cs = *(const f32x4*)(cosa + pos * 32 + f), sn = *(const f32x4*)(sina + pos * 32 + f);
            f32x4 o; o.x = lane_xor<8>(v.x); o.y = lane_xor<8>(v.y); o.z = lane_xor<8>(v.z); o.w = lane_xor<8>(v.w);
            v = half ? (v * cs + o * sn) : (v * cs - o * sn);
        }
        *(unsigned*)(KA8 + ((size_t)(L_lane >> 5) * MH + row) * 128 + (((((L_lane & 31) >> 2) ^ ((row >> 1) & 7)) << 4) | (4 * (L_lane & 3)))) =
            pk4_fp8(__builtin_amdgcn_fmed3f(v.x, -448.f, 448.f), __builtin_amdgcn_fmed3f(v.y, -448.f, 448.f), __builtin_amdgcn_fmed3f(v.z, -448.f, 448.f), __builtin_amdgcn_fmed3f(v.w, -448.f, 448.f));
    }
}

DI void p_vprep(Frame& F, CArgs* ap) {
    const int L_tid = opaque_tid(), L_lane = L_tid & 63, L_wave = __builtin_amdgcn_readfirstlane(L_tid >> 6);
    unsigned char* ws = ap->ws; const int gw = frame_vcu() * NWAVES + L_wave, NGW = ((int)gridDim.x) * NWAVES;
    for (int it = gw; it < (MH / 64) * 2; it += NGW) {
        const int tile = it >> 1, kvh = it & 1;
        const bf16* src = (const bf16*)(ws + WS_VA) + (size_t)tile * 64 * 256 + kvh * 128 + 2 * L_lane;
        unsigned char* dst = ws + WS_VA8 + ((size_t)kvh * (MH / 64) + tile) * 8192 + 128 * L_lane;
        const int x = (L_lane >> 1) & 3;
#pragma unroll
        for (int c = 0; c < 4; ++c) {
            v4u lo, hi_;
#pragma unroll
            for (int e = 0; e < 4; ++e) { const int q = 4 * c + e, k0 = 32 * ((q >> 2) & 1) + 8 * (q & 3) + 4 * (q >> 3);
                const unsigned w0 = *(const unsigned*)(src + (k0 + 0) * 256), w1 = *(const unsigned*)(src + (k0 + 1) * 256), w2 = *(const unsigned*)(src + (k0 + 2) * 256), w3 = *(const unsigned*)(src + (k0 + 3) * 256);
#define VQ(v) __builtin_amdgcn_fmed3f((v) * 8.0f, -448.f, 448.f)
                lo[e] = pk4_fp8(VQ(bf_lo(w0)), VQ(bf_lo(w1)), VQ(bf_lo(w2)), VQ(bf_lo(w3))); hi_[e] = pk4_fp8(VQ(bf_hi(w0)), VQ(bf_hi(w1)), VQ(bf_hi(w2)), VQ(bf_hi(w3)));
#undef VQ
            }
            *(v4u*)(dst + ((c ^ x) << 4)) = lo; *(v4u*)(dst + 64 + ((c ^ x) << 4)) = hi_;
        }
    }
}
DI void p_router(Frame& F, CArgs* ap) {
    const int L_tid = opaque_tid(), L_lane = L_tid & 63, L_wave = __builtin_amdgcn_readfirstlane(L_tid >> 6);
    unsigned char* ws = ap->ws; const int gw = frame_vcu() * NWAVES + L_wave, NGW = ((int)gridDim.x) * NWAVES;
    LAS float* wrs = (LAS float*)F.lds;
    LAS float* xs = (LAS float*)(F.lds + 16384) + L_wave * (32 * 129);
    const float* mod = (const float*)(ws + WS_MOD); const float* x1 = ap->out; unsigned char* H2 = (unsigned char*)(ws + WS_H2);
    int* tope = (int*)(ws + WS_TOPE); float* topw = (float*)(ws + WS_TOPW); int* wcnt = (int*)(ws + WS_WCNT);
    const int e_l = L_lane & 31, hi = L_lane >> 5; const float bias = ap->in[I_BR][e_l];
    const int nit = (TTOK / 32 + NGW - 1) / NGW;
    for (int it = 0; it < nit; ++it) {
        const int ch = gw + it * NGW; const bool active = ch < TTOK / 32; const int chc = active ? ch : 0;
        const int b = (chc * 32) / SEQ; float rs = 0.f;
        {
            f32x4 pa[4], pb[4];
#pragma unroll
            for (int j = 0; j < 4; ++j) { const int k = 512 * (j >> 1) + 8 * L_lane + 4 * (j & 1); const f32x4 g = *(const f32x4*)(ap->in[I_NORM2] + k), sh = *(const f32x4*)(mod + (size_t)b * 6144 + 3072 + k), sc = *(const f32x4*)(mod + (size_t)b * 6144 + 4096 + k);
                pa[j] = g * (sc + 1.0f); pb[j] = sh; }
            if (active) for (int tb = 0; tb < 32; tb += 4) {
                v4u raw[4][2];
#pragma unroll
                for (int q = 0; q < 4; ++q) { const bf16* src = (const bf16*)(x1 + (size_t)(ch * 32 + tb + q) * DM);
#pragma unroll
                    for (int j = 0; j < 2; ++j) raw[q][j] = *((const GAS v4u*)src + 64 * j + L_lane); }
#pragma unroll
                for (int q = 0; q < 4; ++q) { const int tt = tb + q, t = ch * 32 + tt; float s = 0.f; f32x4 v[4];
                    pg8::unpack8(raw[q][0], v[0], v[1]); pg8::unpack8(raw[q][1], v[2], v[3]);
#pragma unroll
                    for (int j = 0; j < 4; ++j) s += (v[j].x * v[j].x + v[j].y * v[j].y) + (v[j].z * v[j].z + v[j].w * v[j].w);
                    const float rstd = 1.0f / sqrtf(wave_sum(s) * (1.0f / DM) + EPS);
                    rs = (e_l == tt) ? rstd : rs;
                    GAS v2u* o = (GAS v2u*)(H2 + (size_t)t * DM) + L_lane;
#pragma unroll
                    for (int j = 0; j < 2; ++j) { const f32x4 y0 = v[2 * j] * rstd * pa[2 * j] + pb[2 * j], y1 = v[2 * j + 1] * rstd * pa[2 * j + 1] + pb[2 * j + 1];
                        v2u w; w.x = pk4_fp8(4.f * y0.x, 4.f * y0.y, 4.f * y0.z, 4.f * y0.w); w.y = pk4_fp8(4.f * y1.x, 4.f * y1.y, 4.f * y1.z, 4.f * y1.w); o[64 * j] = w; } }
            }
        }
        f32x16 acc = {};
        v2u xr[16];
#pragma unroll
        for (int i2 = 0; i2 < 16; ++i2) xr[i2] = *(const GAS v2u*)((const bf16*)(x1 + (size_t)(chc * 32 + 2 * i2 + hi) * DM) + 4 * e_l);
        for (int sl = 0; sl < 8; ++sl) {
            __syncthreads();
            { const f32x4* wsrc = (const f32x4*)(ap->in[I_WR] + (size_t)sl * 128 * 32); for (int i = L_tid; i < 1024; i += 512) *(LAS f32x4*)(wrs + 4 * i) = wsrc[i]; }
            const int k4 = sl * 128 + 4 * e_l; const f32x4 g = *(const f32x4*)(ap->in[I_NORM2] + k4), sh = *(const f32x4*)(mod + (size_t)b * 6144 + 3072 + k4), sc = *(const f32x4*)(mod + (size_t)b * 6144 + 4096 + k4);
            const f32x4 pa = g * (sc + 1.0f);
#pragma unroll
            for (int i2 = 0; i2 < 16; ++i2) { const int tok = 2 * i2 + hi; const float r = __shfl(rs, tok);
                const f32x4 x = {bf_lo(xr[i2].x), bf_hi(xr[i2].x), bf_lo(xr[i2].y), bf_hi(xr[i2].y)}; const f32x4 y = x * r * pa + sh;
                LAS float* d = xs + tok * 129 + 4 * e_l; d[0] = y.x; d[1] = y.y; d[2] = y.z; d[3] = y.w; }
            { const int kn = (sl < 7 ? sl + 1 : 7) * 128 + 4 * e_l;
#pragma unroll
                for (int i2 = 0; i2 < 16; ++i2) xr[i2] = *(const GAS v2u*)((const bf16*)(x1 + (size_t)(chc * 32 + 2 * i2 + hi) * DM) + kn); }
            __syncthreads();
#pragma unroll 8
            for (int s = 0; s < 64; ++s) acc = __builtin_amdgcn_mfma_f32_32x32x2f32(xs[e_l * 129 + 2 * s + hi], wrs[(2 * s + hi) * 32 + e_l], acc, 0, 0, 0);
        }
        int cnt = 0;
#pragma unroll
        for (int g = 0; g < 16; ++g) {
            const int tok = (g & 3) + 8 * (g >> 2) + 4 * hi; float lv = acc[g] + bias; int se[4]; float sv[4];
#pragma unroll
            for (int k = 0; k < 4; ++k) { float bv = lv; int be = e_l;
#pragma unroll
                for (int o = 1; o < 32; o <<= 1) { const float ov = __shfl_xor(bv, o); const int oe = __shfl_xor(be, o); if (ov > bv || (ov == bv && oe < be)) { bv = ov; be = oe; } }
                se[k] = be; sv[k] = bv; if (e_l == be) { lv = -3.0e38f; ++cnt; } }
            const float e1 = __expf(sv[1] - sv[0]), e2 = __expf(sv[2] - sv[0]), e3 = __expf(sv[3] - sv[0]); const float inv = 1.0f / (1.0f + e1 + e2 + e3);
            if (active && e_l == 0) { const int t = ch * 32 + tok; *(int4*)(tope + (size_t)t * 4) = make_int4(se[0], se[1], se[2], se[3]); *(float4*)(topw + (size_t)t * 4) = make_float4(inv, e1 * inv, e2 * inv, e3 * inv); }
        }
        cnt += __shfl_xor(cnt, 32);
        if (active && L_lane < 32) wcnt[ch * 32 + L_lane] = cnt;
    }
}

DI void p_sort(Frame& F, CArgs* ap, const int th) {
    const int L_tid = opaque_tid(), L_lane = L_tid & 63, L_wave = __builtin_amdgcn_readfirstlane(L_tid >> 6);
    unsigned char* ws = ap->ws; const int gw = frame_vcu() * NWAVES + L_wave, NGW = ((int)gridDim.x) * NWAVES;
    LAS int* cnt = (LAS int*)F.lds;
    LAS int* segsum = (LAS int*)(F.lds + MISC_OFF + 256);
    LAS int* tot = segsum + 512;
    LAS int* tileb = tot + 32;
    const int* wc = (const int*)(ws + WS_WCNT) + (size_t)th * 1024 * 32;
    for (int i = L_tid; i < 1024 * 32 / 4; i += 512) *(LAS v4u*)(cnt + 4 * i) = *(const v4u*)(wc + 4 * i);
    __syncthreads();
    { const int e = L_tid & 31, seg = L_tid >> 5; int s = 0; for (int w = 0; w < 64; ++w) s += cnt[(seg * 64 + w) * 32 + e]; segsum[seg * 32 + e] = s; }
    __syncthreads();
    if (L_tid < 32) { int s = 0; for (int g = 0; g < 16; ++g) s += segsum[g * 32 + L_tid]; tot[L_tid] = s; }
    __syncthreads();
    if (L_tid == 0) { int a = 0; for (int e = 0; e < 32; ++e) { tileb[e] = a; a += (tot[e] + 255) >> 8; } tileb[32] = a; }
    __syncthreads();
    int* rowtok = (int*)(ws + WS_ROWTOK); int* rowdst = (int*)(ws + WS_ROWDST) + (size_t)th * TH_TOK * 4; float* roww = (float*)(ws + WS_ROWW);
    const int vcu_ = frame_vcu(), G_ = (int)gridDim.x;
    if (vcu_ == G_ - 1) { int* tb = (int*)(ws + WS_TILEB); if (L_tid < 33) tb[L_tid] = tileb[L_tid];
        for (int t = L_tid; t < tileb[32]; t += 512) { int e = 0; for (int q = 1; q < 32; ++q) if (t >= tileb[q]) e = q; tb[64 + t] = e; } }
    if (vcu_ >= G_ - 33 && vcu_ < G_ - 1) { const int e = vcu_ - (G_ - 33); const int r0 = tileb[e] * 256 + tot[e], r1 = tileb[e + 1] * 256;
        for (int r = r0 + L_tid; r < r1; r += 512) { rowtok[r] = th * TH_TOK; roww[r] = 0.f; } }
    const int* tope = (const int*)(ws + WS_TOPE); const float* topw = (const float*)(ws + WS_TOPW);
    for (int wcl = gw; wcl < 1024; wcl += NGW) {
        int run = 0;
        { const int e = L_lane & 31, h = L_lane >> 5, seg = wcl >> 6; int a = 0;
#pragma unroll 4
            for (int g = h; g < seg; g += 2) a += segsum[g * 32 + e];
#pragma unroll 4
            for (int w = seg * 64 + h; w < wcl; w += 2) a += cnt[w * 32 + e];
            const auto sw_ = __builtin_amdgcn_permlane32_swap((unsigned)a, (unsigned)a, false, false);
            run = tileb[e] * 256 + (int)(sw_[0] + sw_[1]); }
#pragma unroll 1
        for (int tt = 0; tt < 32; ++tt) {
            const int t = th * TH_TOK + wcl * 32 + tt; const int4 es = *(const int4*)(tope + (size_t)t * 4); const float4 wsv = *(const float4*)(topw + (size_t)t * 4);
            const int ee[4] = {es.x, es.y, es.z, es.w}; const float wv[4] = {wsv.x, wsv.y, wsv.z, wsv.w};
#pragma unroll
            for (int s = 0; s < 4; ++s) { const int pos = __shfl(run, ee[s]); if (L_lane == ee[s]) ++run;
                if (L_lane == 0) { rowtok[pos] = t; rowdst[(wcl * 32 + tt) * 4 + s] = pos; roww[pos] = wv[s]; } }
        }
    }
}

DI void p_combine(Frame& F, CArgs* ap, const int th) {
    const int L_tid = opaque_tid(), L_lane = L_tid & 63, L_wave = __builtin_amdgcn_readfirstlane(L_tid >> 6);
    unsigned char* ws = ap->ws; const int gw = frame_vcu() * NWAVES + L_wave, NGW = ((int)gridDim.x) * NWAVES;
    const float* mod = (const float*)(ws + WS_MOD); const bf16* Y2 = (const bf16*)(ws + WS_Y2); const int* tokpos = (const int*)(ws + WS_ROWDST) + (size_t)th * TH_TOK * 4;
    for (int tl = gw; tl < TH_TOK; tl += NGW) {
        const int t = th * TH_TOK + tl, b = t / SEQ; const int4 pp = *(const int4*)(tokpos + (size_t)tl * 4); const int prow[4] = {pp.x, pp.y, pp.z, pp.w};
        float* op = ap->out + (size_t)t * DM; const bf16* xb = (const bf16*)op;
        v4u xr[2]; f32x4 a[2][2], gq[2][2];
#pragma unroll
        for (int jj = 0; jj < 2; ++jj) { const int c0 = 512 * jj + 8 * L_lane;
            xr[jj] = *(const v4u*)(xb + c0); a[jj][0] = (f32x4){0.f, 0.f, 0.f, 0.f}; a[jj][1] = (f32x4){0.f, 0.f, 0.f, 0.f};
#pragma unroll
            for (int s = 0; s < 4; ++s) { f32x4 y0, y1; pg8::unpack8(*(const v4u*)(Y2 + (size_t)prow[s] * 1024 + c0), y0, y1); a[jj][0] += y0; a[jj][1] += y1; }
            gq[jj][0] = *(const f32x4*)(mod + (size_t)b * 6144 + 5120 + c0); gq[jj][1] = *(const f32x4*)(mod + (size_t)b * 6144 + 5120 + c0 + 4); }
        asm volatile("s_waitcnt vmcnt(0)" ::: "memory");
#pragma unroll
        for (int jj = 0; jj < 2; ++jj) { const int c0 = 512 * jj + 8 * L_lane; f32x4 x0, x1v; pg8::unpack8(xr[jj], x0, x1v);
            *(f32x4*)(op + c0) = x0 + gq[jj][0] * a[jj][0]; *(f32x4*)(op + c0 + 4) = x1v + gq[jj][1] * a[jj][1]; }
    }
}

#ifdef DIAG_ATT
#ifndef DIAG_BL
#define DIAG_BL 0
#endif
#ifndef DIAG_HALF
#define DIAG_HALF 0
#endif
constexpr size_t WS_DIAG = 1015 * MiB;
constexpr size_t WS_DIAG_Q = WS_DIAG + 5 * MiB, WS_DIAG_S = WS_DIAG + 6 * MiB, WS_DIAG_R = WS_DIAG + 7 * MiB;
__device__ const int diag_h[8] = {0, 1, 2, 3, 4, 5, 6, 7};
__device__ const int diag_t[8] = {0, 63, 64, 1000, 4095, 4873, 8000, 8191};
DI void diag_pre_k(Frame& F, CArgs* ap) {
    unsigned char* ws = ap->ws; const int tid = opaque_tid();
    const v4u* src = (const v4u*)(ws + WS_KA) + (size_t)DIAG_BL * LT * 256 / 8; v4u* dst = (v4u*)(ws + WS_DIAG);
    for (int i = blockIdx.x * 512 + tid; i < LT * 256 / 8; i += ((int)gridDim.x) * 512) dst[i] = src[i];
}
DI void diag_pre_q(Frame& F, CArgs* ap) {
    unsigned char* ws = ap->ws; const int tid = opaque_tid();
    if (blockIdx.x == 0) { const bf16* QA = (const bf16*)(ws + WS_QA); bf16* dq = (bf16*)(ws + WS_DIAG_Q);
        for (int i = tid; i < 8 * 128; i += 512) { const int s = i >> 7, d = i & 127; dq[i] = QA[(size_t)(DIAG_BL * LT + LCTX + diag_t[s]) * 1024 + diag_h[s] * 128 + d]; } }
}
DI void diag_normrope(float* x  , const float* gain, int t, bool rope, int lane) {
    float a = x[lane], b = x[lane + 64]; float ss = wave_sum(a * a + b * b); const float rstd = 1.0f / sqrtf(ss / 128.0f + EPS);
    a *= rstd * gain[lane]; b *= rstd * gain[lane + 64]; x[lane] = a; x[lane + 64] = b;
    asm volatile("s_waitcnt lgkmcnt(0)" ::: "memory");
    if (rope) {
        float o[2];
        for (int q = 0; q < 2; ++q) { const int d = lane + 64 * q, axis = d >> 6, half = (d >> 5) & 1, f = d & 31; const float pos = axis ? (float)(t & 63) : (float)(t >> 6);
            const float ang = pos * powf(10000.0f, -(float)f / 32.0f); const float cs = cosf(ang), sn = sinf(ang); const float me = x[d], other = x[d ^ 32];
            o[q] = half ? (me * cs + other * sn) : (me * cs - other * sn); }
        asm volatile("s_waitcnt lgkmcnt(0)" ::: "memory");
        x[lane] = o[0]; x[lane + 64] = o[1];
        asm volatile("s_waitcnt lgkmcnt(0)" ::: "memory");
    }
}
DI void diag_post(Frame& F, CArgs* ap, LAS unsigned char* lds) {
    if (blockIdx.x != 0) return;
    unsigned char* ws = ap->ws; const int tid = opaque_tid(), lane = tid & 63, w = tid >> 6;
    float* xq = (float*)(lds) + w * 256; float* xk = xq + 128;
    const bf16* dq = (const bf16*)(ws + WS_DIAG_Q); const bf16* K = (const bf16*)(ws + WS_DIAG); const bf16* V = (const bf16*)(ws + WS_VA) + (size_t)DIAG_BL * LT * 256; float* S = (float*)(ws + WS_DIAG_S) + (size_t)w * LT;
    const int h = diag_h[w], t = diag_t[w], kvh = h >> 2;
    xq[lane] = __uint_as_float((unsigned)dq[w * 128 + lane] << 16); xq[lane + 64] = __uint_as_float((unsigned)dq[w * 128 + lane + 64] << 16);
    asm volatile("s_waitcnt lgkmcnt(0)" ::: "memory");
    diag_normrope(xq, ap->in[I_QN], t, true, lane);
    float mx = -1e30f;
    for (int j = 0; j < LT; ++j) {
        xk[lane] = __uint_as_float((unsigned)K[(size_t)j * 256 + kvh * 128 + lane] << 16); xk[lane + 64] = __uint_as_float((unsigned)K[(size_t)j * 256 + kvh * 128 + lane + 64] << 16);
        asm volatile("s_waitcnt lgkmcnt(0)" ::: "memory");
        diag_normrope(xk, ap->in[I_KN], j - LCTX, j >= LCTX, lane);
        const float sc = wave_sum(xq[lane] * xk[lane] + xq[lane + 64] * xk[lane + 64]) * 0.088388347648318440f;
        if (lane == 0) S[j] = sc; mx = fmaxf(mx, sc);
    }
    asm volatile("s_waitcnt vmcnt(0)" ::: "memory");
    float l = 0.f, o0 = 0.f, o1 = 0.f;
    for (int j = 0; j < LT; ++j) { const float p = __expf(__hip_atomic_load(S + j, __ATOMIC_RELAXED, __HIP_MEMORY_SCOPE_AGENT) - mx); l += p;
        o0 += p * __uint_as_float((unsigned)V[(size_t)j * 256 + kvh * 128 + lane] << 16); o1 += p * __uint_as_float((unsigned)V[(size_t)j * 256 + kvh * 128 + lane + 64] << 16); }
    o0 /= l; o1 /= l;
    const bf16* O = (const bf16*)(ws + WS_QA) + (size_t)(DIAG_BL * LT + LCTX + t) * 1024 + h * 128;
    const float f0 = __uint_as_float((unsigned)O[lane] << 16), f1 = __uint_as_float((unsigned)O[lane + 64] << 16);
    float err = fmaxf(fabsf(f0 - o0), fabsf(f1 - o1)), mag = fmaxf(fabsf(o0), fabsf(o1));
#define WMAX(x) do { x = fmaxf(x, lane_xor<1>(x)); x = fmaxf(x, lane_xor<2>(x)); x = fmaxf(x, lane_xor<4>(x)); x = fmaxf(x, lane_xor<8>(x)); x = fmaxf(x, lane_xor<16>(x)); \
      auto rr = __builtin_amdgcn_permlane32_swap(__float_as_uint(x), __float_as_uint(x), false, false); x = fmaxf(__uint_as_float(rr[0]), __uint_as_float(rr[1])); } while (0)
    WMAX(err); WMAX(mag);
#undef WMAX
    float* red = (float*)(lds + 16384);
    if (lane == 0) red[w] = err / mag;
    __syncthreads();
    if (tid == 0) { float m = 0.f; for (int q = 0; q < 8; ++q) m = fmaxf(m, red[q]); *(float*)(ws + WS_DIAG_R) = m; }
}
#endif
#ifndef REP_P0
#define REP_P0 1
#endif
#ifndef REP_ROUTER
#define REP_ROUTER 1
#endif
#ifndef REP_GA
#define REP_GA 1
#endif
#ifndef REP_GC
#define REP_GC 1
#endif
#ifndef REP_GM
#define REP_GM 1
#endif
#ifndef REP_GM4
#define REP_GM4 REP_GM
#endif
#ifndef REP_RET
#define REP_RET 1
#endif
#ifndef REP_PASS
#define REP_PASS 1
#endif
__global__ void __launch_bounds__(NWAVES * 64, 2) mk_fwd(Args args) {
    extern __shared__ __attribute__((aligned(16))) unsigned char lds[];
    Frame F;
    F.lds = (LAS unsigned char*)lds;
    F.MISC = (volatile LAS unsigned*)(F.lds + MISC_OFF);
    for (int u = threadIdx.x; u < (LDS_BYTES - LDSCTL_OFF) / 4; u += NWAVES * 64) ((LAS unsigned*)(F.lds + LDSCTL_OFF))[u] = 0u;
    __syncthreads();
    if ((threadIdx.x & 63) == 0) ((LAS int*)(F.lds + LDSCTL_OFF))[hw_wave_key()] = (int)(threadIdx.x >> 6);
    __syncthreads();
    (void)xcd_barrier_post((unsigned*)((gu32*)(kargs()->ws + WS_CTL) + CW_BAR), F.MISC + 8);
#define GRID_BAR() do { XcdBarrier bb_; bb_.bar = (unsigned*)((gu32*)(kargs()->ws + WS_CTL) + CW_BAR); bb_.x = (unsigned)__builtin_amdgcn_readfirstlane((int)xb_xcc_id()); \
        bb_.st = (volatile LAS unsigned*)(uintptr_t)(MISC_OFF + 32); xcd_barrier(bb_); } while (0)
#ifndef SKIP_P0
    for (int rep_ = 0; rep_ < REP_P0; ++rep_) { p0_prologue(F, kargs()); __syncthreads(); }
#endif
    GRID_BAR();
#ifndef SKIP_MODU
    for (int rep_ = 0; rep_ < REP_PASS; ++rep_) { p_modulate(F, kargs()); __syncthreads(); }
#endif
    GRID_BAR();

#pragma unroll 1
    for (int half = 0; half < 2; ++half) {
#define H1h ((const unsigned char*)(ws + WS_H1) + (size_t)half * MH * DM)
#define Yh ((bf16*)(ws + WS_Y))
#define Y8h ((unsigned char*)(ws + WS_H1) + (size_t)half * MH * DM)
#ifndef SKIP_A1
        for (int rep_ = 0; rep_ < REP_GA; ++rep_) { CArgs* ap = kargs(); unsigned char* ws = ap->ws;
            pg8::SchedA1 S{((int)gridDim.x), (int)blockIdx.x, 1};
            pg8::EpiA1 E{(bf16*)(ws + WS_QR), (bf16*)(ws + WS_KR), (bf16*)(ws + WS_VR), (bf16*)(ws + WS_KA), (bf16*)(ws + WS_VA), (const float*)(ws + WS_COSR), (const float*)(ws + WS_SINR)};
            pg8::gemm_phase<pg8::EpiA1, pg8::SchedA1, false, true>(F.lds + RING_OFF, H1h, ws + WS_WIN, DM, DM, DM, S, E, nullptr);
        }
#endif
        GRID_BAR();
#ifndef SKIP_RET
        for (int rep_ = 0; rep_ < REP_RET; ++rep_)
        for (int u = frame_vcu(); u < 256; u += ((int)gridDim.x)) { CArgs* ap = kargs(); unsigned char* ws = ap->ws;
            const int bh = u >> 4, bl = bh >> 2, h = bh & 3, dir = (u >> 3) & 1, sl = u & 7;
            const float raw = ap->in[dir ? I_DECB : I_DECF][h];
            const float lg = -log1pf(expf(raw));
            ret::ret_unit(F.lds + RING_OFF, (const bf16*)(ws + WS_QR), (const bf16*)(ws + WS_KR), (const bf16*)(ws + WS_VR), (bf16*)(ws + (dir ? WS_OB : WS_OF)), bl * LT, h, dir == 0, sl, lg);
        }
#endif
        GRID_BAR();
#ifdef DIAG_ATT
        if (half == DIAG_HALF) diag_pre_k(F, kargs());
        GRID_BAR();
#endif
#ifndef SKIP_B2
        p_knorm(F, kargs()); p_vprep(F, kargs());
#endif
#ifndef SKIP_B1
        for (int rep_ = 0; rep_ < REP_GA; ++rep_) { CArgs* ap = kargs(); unsigned char* ws = ap->ws;
            pg8::SchedB1 S{((int)gridDim.x), (int)blockIdx.x, 1};
            pg8::EpiB1 E{(bf16*)(ws + WS_GR), (bf16*)(ws + WS_QA), (bf16*)(ws + WS_KA), (bf16*)(ws + WS_VA), (bf16*)(ws + WS_GTR), (bf16*)(ws + WS_GTA)};
            pg8::gemm_phase<pg8::EpiB1, pg8::SchedB1, false, true>(F.lds + RING_OFF, H1h, ws + WS_WIN + (size_t)4096 * DM, DM, DM, DM, S, E, nullptr);
        }
#endif
        GRID_BAR();
#ifdef DIAG_ATT
        if (half == DIAG_HALF) diag_pre_q(F, kargs());
        GRID_BAR();
#endif
        const int ar_slot_ = frame_vcu() % (1024 / (int)gridDim.x + 1);
#ifndef SKIP_ATT
        for (int u = frame_vcu(); u < 1024; u += ((int)gridDim.x)) { CArgs* ap = kargs(); unsigned char* ws = ap->ws;
#ifndef SKIP_B2
            if ((u - frame_vcu()) / (int)gridDim.x == ar_slot_) p_ar(F, kargs());
#endif
            const int grp = u >> 7, w = u & 127, bl = grp >> 1, kvh = grp & 1, h = kvh * 4 + (w >> 5), qb = w & 31;
            bf16* Qb = (bf16*)(ws + WS_QA) + (size_t)(bl * LT + LCTX + qb * 256) * 1024 + h * 128;
            const unsigned char* Kh = ws + WS_KA8 + ((size_t)kvh * MH + (size_t)bl * LT) * 128;
            const unsigned char* Vh = ws + WS_VA8 + ((size_t)kvh * (MH / 64) + (size_t)bl * (LT / 64)) * 8192;
            att::attn_dense_body(Qb, Kh, Vh, Qb, ws + WS_O8 + (size_t)(bl * LT + LCTX + qb * 256) * 1024 + h * 128, LT, F.lds + RING_OFF, qb * 256, ap->in[I_QN], (const float*)(ws + WS_COSA), (const float*)(ws + WS_SINA));
        }
#endif
#ifndef SKIP_B2
        if (ar_slot_ >= (1024 - frame_vcu() + (int)gridDim.x - 1) / (int)gridDim.x) p_ar(F, kargs());
#endif
        GRID_BAR();
#ifdef DIAG_ATT
        if (half == DIAG_HALF) diag_post(F, kargs(), F.lds);
        GRID_BAR();
#endif
#ifndef SKIP_C12
        for (int rep_ = 0; rep_ < REP_GC; ++rep_) { CArgs* ap = kargs(); unsigned char* ws = ap->ws;
            pg8::SchedLat S1{((int)gridDim.x), (int)blockIdx.x, 4096, 2048};
            pg8::EpiGate<false> E1{Yh, ws + WS_GTR, nullptr};
            pg8::gemm_phase<pg8::EpiGate<false>, pg8::SchedLat, false, true>(F.lds + RING_OFF, ws + WS_GR, ws + WS_WRO, 4096, 2048, 2048, S1, E1, nullptr);
            ap = kargs(); ws = ap->ws;
            pg8::SchedLat S2{((int)gridDim.x), (int)blockIdx.x, 1024, 1024};
            pg8::EpiGate<true> E2{Yh, ws + WS_GTA, Y8h};
            pg8::gemm_phase<pg8::EpiGate<true>, pg8::SchedLat, false, true>(F.lds + RING_OFF, ws + WS_O8, ws + WS_WAO, 1024, 1024, 1024, S2, E2, nullptr);
        }
#endif
        GRID_BAR();
#ifndef SKIP_C3
        for (int rep_ = 0; rep_ < REP_GC; ++rep_) { CArgs* ap = kargs(); unsigned char* ws = ap->ws;
            pg8::SchedLat S{((int)gridDim.x), (int)blockIdx.x, 1024, 1024};
            pg8::EpiOut E{ap->in[I_X], ap->out, (const float*)(ws + WS_MOD), half};
            pg8::gemm_phase<pg8::EpiOut, pg8::SchedLat, false, true>(F.lds + RING_OFF, Y8h, ws + WS_WOUT, 1024, 1024, 1024, S, E, nullptr);
        }
#endif
        if (half == 1) GRID_BAR();
#undef H1h
#undef Yh
#undef Y8h
    }

#ifndef SKIP_ROUTER
    for (int rep_ = 0; rep_ < REP_ROUTER; ++rep_) { p_router(F, kargs()); __syncthreads(); }
#endif
    GRID_BAR();
#pragma unroll 1
    for (int th = 0; th < 2; ++th) {
#ifndef SKIP_SORT
        for (int rep_ = 0; rep_ < REP_PASS; ++rep_) { p_sort(F, kargs(), th); __syncthreads(); }
#endif
        GRID_BAR();
#ifndef SKIP_M3
        for (int rep_ = 0; rep_ < REP_GM; ++rep_) { CArgs* ap = kargs(); unsigned char* ws = ap->ws;
            pg8::SchedMoe S{((int)gridDim.x), (int)blockIdx.x, 8, (const int*)(ws + WS_TILEB), (size_t)2048 * 1024, 1024, 1024, true};
            pg8::EpiSwiglu E{(unsigned char*)(ws + WS_ACT), ap->in[I_B1], (const int*)(ws + WS_TILEB)};
            pg8::gemm_phase<pg8::EpiSwiglu, pg8::SchedMoe, true, true>(F.lds + RING_OFF, ws + WS_H2, ws + WS_W1, 1024, 1024, 1024, S, E, (const int*)(ws + WS_ROWTOK));
        }
#endif
        GRID_BAR();
#ifndef SKIP_M4
        for (int rep_ = 0; rep_ < REP_GM4; ++rep_) { CArgs* ap = kargs(); unsigned char* ws = ap->ws;
            pg8::SchedMoe S{((int)gridDim.x), (int)blockIdx.x, 4, (const int*)(ws + WS_TILEB), (size_t)1024 * 1024, 1024, 1024, false};
            pg8::EpiDown E{(bf16*)(ws + WS_Y2), ap->in[I_B2], (const int*)(ws + WS_TILEB), (const float*)(ws + WS_ROWW)};
            pg8::gemm_phase<pg8::EpiDown, pg8::SchedMoe, false, true>(F.lds + RING_OFF, ws + WS_ACT, ws + WS_W2, 1024, 1024, 1024, S, E, nullptr);
        }
#endif
        GRID_BAR();
#ifndef SKIP_COMB
        p_combine(F, kargs(), th);
#endif
#ifdef DIAG_ATT
        GRID_BAR();
#endif
        __syncthreads();
    }
#ifdef DIAG_FILL
    { CArgs* ap = kargs(); const int tid = opaque_tid(); f32x4 z = {0.f, 0.f, 0.f, 0.f}; for (size_t i = (size_t)blockIdx.x * 512 + tid; i < (size_t)TTOK * DM / 4; i += (size_t)gridDim.x * 512) ((f32x4*)ap->out)[i] = z; }
    GRID_BAR();
#endif
#ifdef DIAG_ATT
    if (blockIdx.x == 0 && opaque_tid() == 0) { CArgs* ap = kargs(); const float v = __hip_atomic_load((const float*)(ap->ws + WS_DIAG_R), __ATOMIC_RELAXED, __HIP_MEMORY_SCOPE_AGENT); ap->out[0] += 1.0e6f * v; }
#endif
#undef GRID_BAR
}

extern "C" void kernel_launch(void* const* d_in, const int* in_sizes, int n_in, void* d_out, int out_size, void* d_ws, size_t ws_size, hipStream_t stream) {
    static int grid = 0;
    if (grid == 0) {
        if (n_in != 22 || in_sizes[0] != TTOK * DM || out_size != TTOK * DM || ws_size < WS_END) {
            fprintf(stderr, "kernel_launch: shape mismatch n_in %d in0 %d out %d ws %zu (need %zu)\n", n_in, n_in > 0 ? in_sizes[0] : -1, out_size, ws_size, (size_t)WS_END); grid = -1; return; }
        int dev = 0, cus = 0, per_cu = 0;
        if (hipGetDevice(&dev) != hipSuccess || hipDeviceGetAttribute(&cus, hipDeviceAttributeMultiprocessorCount, dev) != hipSuccess) { grid = -1; return; }
        if (hipFuncSetAttribute((const void*)mk_fwd, hipFuncAttributeMaxDynamicSharedMemorySize, LDS_BYTES) != hipSuccess) { fprintf(stderr, "kernel_launch: hipFuncSetAttribute failed\n"); grid = -1; return; }
        if (hipOccupancyMaxActiveBlocksPerMultiprocessor(&per_cu, (const void*)mk_fwd, NWAVES * 64, LDS_BYTES) != hipSuccess || per_cu < 1)
            fprintf(stderr, "kernel_launch: occupancy query reports %d\n", per_cu);
        (void)hipGetLastError();
        grid = cus;
    }
    if (grid < 0) return;
    if (hipMemsetAsync((char*)d_ws + WS_CTL, 0, CTL_ZERO_BYTES, stream) != hipSuccess) return;
    Args a{};
    for (int i = 0; i < 22; ++i) a.in[i] = (const float*)d_in[i];
    a.out = (float*)d_out; a.ws = (unsigned char*)d_ws;
    hipLaunchKernelGGL(mk_fwd, dim3(grid), dim3(NWAVES * 64), LDS_BYTES, stream, a);
    const hipError_t le = hipPeekAtLastError();
    if (le != hipSuccess) fprintf(stderr, "kernel_launch: launch failed: %s\n", hipGetErrorName(le));
}
```

```cpp
#include <hip/hip_runtime.h>
#include <cstdio>
#include <cstdint>
#include <cstring>

#define GAS __attribute__((address_space(1)))
#define LAS __attribute__((address_space(3)))
#define DI __device__ __forceinline__
typedef unsigned short bf16;
typedef unsigned v4u __attribute__((ext_vector_type(4)));
typedef unsigned v2u __attribute__((ext_vector_type(2)));
typedef float f32x4 __attribute__((ext_vector_type(4)));
typedef float f32x2 __attribute__((ext_vector_type(2)));
typedef float f32x16 __attribute__((ext_vector_type(16)));
typedef short bf16x8 __attribute__((ext_vector_type(8)));
typedef short s16x4 __attribute__((ext_vector_type(4)));
typedef GAS unsigned gu32;
#define RLX_AGENT __ATOMIC_RELAXED, __HIP_MEMORY_SCOPE_AGENT
#define LDS_WAIT() asm volatile("s_waitcnt lgkmcnt(0)" ::: "memory")
#define VM_WAIT() asm volatile("s_waitcnt vmcnt(0)" ::: "memory")

constexpr int NB = 8, SEQ = 8192, DM = 1024, LCTX = 256;
constexpr int LT = SEQ + LCTX;
constexpr int TTOK = NB * SEQ;
constexpr int MROWS = NB * LT;
constexpr int NBH = 4;
constexpr int MH = NBH * LT;
constexpr int TPB = LT / 256;
constexpr int INW = 9728;
constexpr int NEXP = 32, EFF = 1024;
constexpr float EPS = 1e-6f;
constexpr int NWAVES = 8;

constexpr size_t MiB = 1u << 20;
constexpr size_t WS_CTL = 0, CTL_ZERO_BYTES = 1 * MiB;
constexpr size_t WS_SMALL = 1 * MiB;
constexpr size_t WS_MOD   = WS_SMALL;
constexpr size_t WS_COSR  = WS_SMALL + 256 * 1024;
constexpr size_t WS_SINR  = WS_COSR + 32 * 1024;
constexpr size_t WS_COSA  = WS_SINR + 32 * 1024;
constexpr size_t WS_SINA  = WS_COSA + 16 * 1024;
constexpr size_t WS_TOPE  = WS_SMALL + 1 * MiB;
constexpr size_t WS_TOPW  = WS_SMALL + 2 * MiB;
constexpr size_t WS_WCNT  = WS_SMALL + 3 * MiB;
constexpr size_t WS_ROWTOK = WS_SMALL + 4 * MiB;
constexpr size_t WS_ROWDST = WS_SMALL + 5 * MiB;
constexpr size_t WS_ROWW  = WS_SMALL + 6 * MiB;
constexpr size_t WS_TILEB = WS_SMALL + 7 * MiB;
constexpr size_t TH_TAB = 4 * MiB;
constexpr size_t WS_PART  = WS_SMALL + 8 * MiB;
constexpr size_t WS_WIN  = 17 * MiB;
constexpr size_t WS_WRO  = 36 * MiB;
constexpr size_t WS_WAO  = 40 * MiB;
constexpr size_t WS_WOUT = 42 * MiB;
constexpr size_t WS_W1   = 44 * MiB;
constexpr size_t WS_W2   = 172 * MiB;
constexpr size_t WS_H1   = 236 * MiB;
constexpr size_t WS_Y    = 302 * MiB;
constexpr size_t WS_QR = 368 * MiB, WS_KR = 434 * MiB, WS_VR = 500 * MiB;
constexpr size_t WS_OF = 632 * MiB, WS_OB = 764 * MiB;
constexpr size_t WS_GR = 368 * MiB, WS_QA = 500 * MiB, WS_GTR = 566 * MiB, WS_GTA = 896 * MiB, WS_KA = 962 * MiB, WS_VA = 979 * MiB;
constexpr size_t WS_KA8 = 996 * MiB;
constexpr size_t WS_VA8 = 1005 * MiB;
constexpr size_t WS_O8 = WS_KA;
constexpr size_t WS_END = 1014 * MiB;
constexpr size_t WS_H2 = 236 * MiB;
constexpr size_t WS_ACT = 368 * MiB;
constexpr size_t WS_Y2 = 640 * MiB;
constexpr int TH_TOK = TTOK / 2;
constexpr int ACT_CAP = TH_TOK * 4 + 32 * 256;
static_assert(WS_VA + (size_t)MH * 256 * 2 <= WS_END && WS_KA + (size_t)MH * 256 * 2 <= WS_VA, "ws map");
static_assert(WS_Y2 + (size_t)ACT_CAP * 1024 * 2 <= WS_KA8 && WS_ACT + (size_t)ACT_CAP * 2048 <= WS_Y2, "ws map moe");
constexpr int CW_TMO = 0, CW_CODE = 1;
constexpr int CW_BAR = 4096;

constexpr int RING_OFF = 0, RING_BYTES = 159744;
constexpr int LDSCTL_OFF = RING_BYTES, MISC_OFF = LDSCTL_OFF + 320;
constexpr int LDS_BYTES = 163840;

DI unsigned cvt_pk_bf16(float lo, float hi) { unsigned r; asm volatile("v_cvt_pk_bf16_f32 %0, %1, %2" : "=v"(r) : "v"(lo), "v"(hi)); return r; }
DI unsigned pk4_fp8(float a, float b, float c, float d) { int p = 0; p = __builtin_amdgcn_cvt_pk_fp8_f32(a, b, p, false); p = __builtin_amdgcn_cvt_pk_fp8_f32(c, d, p, true); return (unsigned)p; }
DI float bf_lo(unsigned u) { return __uint_as_float(u << 16); }
DI float bf_hi(unsigned u) { return __uint_as_float(u & 0xffff0000u); }
template <int O> DI float lane_xor(float v) { static_assert(O > 0 && O < 32, "lane_xor"); return __int_as_float(__builtin_amdgcn_ds_swizzle(__float_as_int(v), 0x1f | (O << 10))); }
DI float wave_sum(float v) {
    v += lane_xor<1>(v); v += lane_xor<2>(v); v += lane_xor<4>(v); v += lane_xor<8>(v); v += lane_xor<16>(v);
    auto rr = __builtin_amdgcn_permlane32_swap(__float_as_uint(v), __float_as_uint(v), false, false);
    return __uint_as_float(rr[0]) + __uint_as_float(rr[1]);
}
DI float fast_sigmoid(float x) { return __builtin_amdgcn_rcpf(1.0f + __expf(-x)); }

DI int hw_wave_key() { return (int)__builtin_amdgcn_s_getreg((5 << 11) | 4) & 63; }
DI int opaque_tid() {
    int w = *(volatile LAS int*)(uintptr_t)(LDSCTL_OFF + 4 * hw_wave_key());
    w = __builtin_amdgcn_readfirstlane(w);
    unsigned z; asm volatile("v_mov_b32 %0, 0" : "=v"(z));
    int t = w * 64 + (int)__builtin_amdgcn_mbcnt_hi(~0u, __builtin_amdgcn_mbcnt_lo(~0u, z));
    asm volatile("" : "+v"(t)); return t;
}

DI int fresh_lane() { unsigned z; asm volatile("v_mov_b32 %0, 0" : "=v"(z)); int l = (int)__builtin_amdgcn_mbcnt_hi(~0u, __builtin_amdgcn_mbcnt_lo(~0u, z)); asm volatile("" : "+v"(l)); return l; }

#define XB_TMO      128
#define XB_XCNT(j)  (256  + 64 * (j))
#define XB_XSUB(j)  (1280 + 64 * (j))
#define XB_XGEN(j)  (2304 + 64 * (j))
#define XB_TOP      3328
#define XB_TOPGEN   3392
#define XCD_BAR_WORDS 3456
#define XB_SPIN_CAP (1u << 18)

__device__ __forceinline__ unsigned xb_ld(unsigned* p)              { return __hip_atomic_load(p, __ATOMIC_RELAXED, __HIP_MEMORY_SCOPE_AGENT); }
__device__ __forceinline__ unsigned xb_add(unsigned* p, unsigned v) { return __hip_atomic_fetch_add(p, v, __ATOMIC_RELAXED, __HIP_MEMORY_SCOPE_AGENT); }
__device__ __forceinline__ unsigned xb_xcc_id() { return (unsigned)__builtin_amdgcn_s_getreg((3 << 11) | 20) & 0xFu; }
#define XB_SPIN(cond, bar) do { unsigned _sp = 0; while (cond) { __builtin_amdgcn_s_sleep(1); \
    if ((++_sp & 255u) == 0u) { if (xb_ld(&(bar)[XB_TMO])) break; if (_sp > XB_SPIN_CAP) { atomicAdd(&(bar)[XB_TMO], 1u); break; } } } } while (0)

struct XcdBarrier {
    unsigned* bar; unsigned x;
    volatile LAS unsigned* st;
};

__device__ __forceinline__ XcdBarrier xcd_barrier_post(unsigned* bar, volatile LAS unsigned* st) {
    XcdBarrier b; b.bar = bar; b.x = xb_xcc_id(); b.st = st;
    if (opaque_tid() == 0) (void)xb_add(&bar[XB_XCNT(b.x)], 1u);
    return b;
}
__device__ __forceinline__ void xcd_barrier_complete(unsigned* bar, unsigned x, unsigned& nloc, unsigned& nx) {
    const unsigned G = gridDim.x * gridDim.y * gridDim.z;
    unsigned sum, cnt, mine, sp = 0u;
    for (;;) {
        sum = 0u; cnt = 0u; mine = 0u;
#pragma unroll
        for (unsigned j = 0; j < 16; ++j) { const unsigned c = xb_ld(&bar[XB_XCNT(j)]); sum += c; cnt += (c > 0u) ? 1u : 0u; mine = (j == x) ? c : mine; }
        if (sum == G) break;
        __builtin_amdgcn_s_sleep(1);
        if ((++sp & 255u) == 0u) { if (xb_ld(&bar[XB_TMO])) break; if (sp > XB_SPIN_CAP) { atomicAdd(&bar[XB_TMO], 1u); break; } }
    }
    nloc = mine > 0u ? mine : 1u; nx = cnt > 0u ? cnt : 1u;
}

__device__ __forceinline__ void xcd_barrier(const XcdBarrier& b) {
    asm volatile("s_waitcnt vmcnt(0)" ::: "memory");
    __syncthreads();
    if (opaque_tid() == 0) {
        unsigned* bar = b.bar;
        __builtin_amdgcn_s_waitcnt(0);
        unsigned nloc = b.st[0], nx = b.st[1];
        if (nloc == 0u) { xcd_barrier_complete(bar, b.x, nloc, nx); b.st[0] = nloc; b.st[1] = nx; }
        const unsigned old = xb_add(&bar[XB_XSUB(b.x)], 1u);
        const unsigned gen = old / nloc;
        if (old + 1u == (gen + 1u) * nloc) {
            __builtin_amdgcn_fence(__ATOMIC_RELEASE, "agent");
            asm volatile("s_waitcnt vmcnt(0)" ::: "memory");
            const unsigned og = xb_add(&bar[XB_TOP], 1u);
            const unsigned tg = og / nx;
            if (og + 1u == (tg + 1u) * nx) xb_add(&bar[XB_TOPGEN], 1u);
            else XB_SPIN(xb_ld(&bar[XB_TOPGEN]) == tg, bar);
            __builtin_amdgcn_fence(__ATOMIC_ACQUIRE, "agent");
            xb_add(&bar[XB_XGEN(b.x)], 1u);
            asm volatile("s_waitcnt vmcnt(0)" ::: "memory");
        } else {
            XB_SPIN(xb_ld(&bar[XB_XGEN(b.x)]) == gen, bar);
            __builtin_amdgcn_fence(__ATOMIC_ACQUIRE, "agent");
            asm volatile("s_waitcnt vmcnt(0)" ::: "memory");
        }
    }
    __syncthreads();
}
namespace pg8 {
#define PG8_LAS __attribute__((address_space(3)))
constexpr int BM = 256, BK = 64, HALF = 128, HTB = HALF * BK * 2, STAGE_BYTES = 8 * HTB, NXCD = 8, WGM = 8;
__host__ __device__ __forceinline__ int lds_byte(int r, int c) { const int st = (r >> 4) * 2 + (c >> 5), rr = r & 15, cc = c & 31, ob = rr * 64 + cc * 2; return st * 1024 + (ob ^ (((ob >> 9) & 1) << 5)); }
__host__ __device__ __forceinline__ void stage_rc(int b, int& R, int& C) { const int st = b / 1024, sb = b % 1024, swz = sb ^ (((sb >> 9) & 1) << 5); R = (st >> 1) * 16 + swz / 64; C = (st & 1) * 32 + (swz % 64) / 2; }
__host__ __device__ __forceinline__ int perm32(int rho) { const int n = rho >> 4, i = rho & 15; return 8 * (i >> 2) + 4 * n + (i & 3); }

struct Unit { int pm, pn; size_t aoff, boff; int grow; };

DI void tile_order(int L, int nM, int nN, int& pm, int& pn) {
    const int nwg = nM * nN; int wgid = L;
    { const int q = nwg / NXCD, r = nwg % NXCD, xcd = wgid % NXCD, off = wgid / NXCD; wgid = (xcd < r ? xcd * (q + 1) : r * (q + 1) + (xcd - r) * q) + off; }
    const int nig = WGM * nN, gid = wgid / nig, fm = gid * WGM, gsz = (nM - fm) < WGM ? (nM - fm) : WGM;
    pm = fm + ((wgid % nig) % gsz); pn = (wgid % nig) / gsz;
}

typedef int v8i32 __attribute__((ext_vector_type(8)));
template <class Epi, class Sched, bool GATHER, bool FP8 = false>
__device__ __forceinline__ void gemm_phase(PG8_LAS unsigned char* lds, const void* A, const void* Bt, const int lda_e, const int ldb_e, const int K, const Sched& S, const Epi& E, const int* __restrict__ gtab) {
    constexpr int ESZ = FP8 ? 1 : 2; const int lda = lda_e * ESZ, ldb = ldb_e * ESZ;
    const int tid = opaque_tid(), wid = __builtin_amdgcn_readfirstlane(tid >> 6), lane = tid & 63, wr = wid >> 2, wc = wid & 3, fr = lane & 15, fq = lane >> 4;
    const int nt = K * ESZ / (BK * 2);
    unsigned voffA[2], voffB[2]; int stR[2], stC[2];
#pragma unroll
    for (int i = 0; i < 2; ++i) { int R, C; stage_rc(tid * 16 + i * 8192, R, C); const int Rb = Epi::PERM ? ((R & ~31) + perm32(R & 31)) : R;
        stR[i] = R; stC[i] = C; voffA[i] = (unsigned)(R * lda + C * 2); voffB[i] = (unsigned)(Rb * ldb + C * 2); }
    const size_t kstep = (size_t)(BK * 2);
    const size_t hstepA = (size_t)HALF * lda, hstepB = (size_t)HALF * ldb;
    const unsigned ldsw = (unsigned)wid * 1024u;
    int aoff = lds_byte(wr * 64 + fr, fq * 8); asm volatile("" : "+v"(aoff));
    int boff = lds_byte(wc * 32 + fr, fq * 8) + 4 * HTB;
    asm volatile("" : "+v"(boff));
#define PG8_SA(b, h) (((b) * 2 + (h)) * HTB)
#define PG8_SB(b, h) ((4 + (b) * 2 + (h)) * HTB)
#define PG8_SBR(b, h) (((b) * 2 + (h)) * HTB)
#define PG8_STAGE(bufoff, gbase, voff) do { _Pragma("unroll") for (int _i = 0; _i < 2; ++_i) { unsigned _vo = (voff)[_i]; asm volatile("" : "+v"(_vo)); \
        __builtin_amdgcn_global_load_lds((const unsigned*)((const char*)(gbase) + _vo), (PG8_LAS unsigned*)(lds + (bufoff) + ldsw + _i * 8192), 16, 0, 0); } } while (0)
#define PG8_STAGE_A(bufoff, p, h, go) do { if constexpr (GATHER) { _Pragma("unroll") for (int _i = 0; _i < 2; ++_i) { unsigned _vo = (go)[(h) * 2 + _i]; asm volatile("" : "+v"(_vo)); \
        __builtin_amdgcn_global_load_lds((const unsigned*)((const char*)(p) + _vo), (PG8_LAS unsigned*)(lds + (bufoff) + ldsw + _i * 8192), 16, 0, 0); } } \
        else { PG8_STAGE(bufoff, (p) + (h) * hstepA, voffA); } } while (0)
#define PG8_LD16(off) (*(const PG8_LAS v4u*)(lds + (off)))
#define PG8_LDA(dst, b, h) do { _Pragma("unroll") for (int m = 0; m < 4; ++m) dst[m] = __builtin_shufflevector(PG8_LD16(PG8_SA(b, h) + aoff + m * 2048), PG8_LD16(PG8_SA(b, h) + aoff + m * 2048 + 1024), 0, 1, 2, 3, 4, 5, 6, 7); } while (0)
#define PG8_LDB(dst, b, h) do { _Pragma("unroll") for (int n = 0; n < 2; ++n) dst[n] = __builtin_shufflevector(PG8_LD16(PG8_SBR(b, h) + boff + n * 2048), PG8_LD16(PG8_SBR(b, h) + boff + n * 2048 + 1024), 0, 1, 2, 3, 4, 5, 6, 7); } while (0)
#define PG8_HALF(x, k) __builtin_bit_cast(bf16x8, __builtin_shufflevector((x), (x), 4 * (k), 4 * (k) + 1, 4 * (k) + 2, 4 * (k) + 3))
#define PG8_MMA(ai, bj, At, Bt_) do { __builtin_amdgcn_s_setprio(1); _Pragma("unroll") for (int m = 0; m < 4; ++m) _Pragma("unroll") for (int n = 0; n < 2; ++n) { \
        if constexpr (FP8) acc[ai][bj][m][n] = __builtin_amdgcn_mfma_scale_f32_16x16x128_f8f6f4(__builtin_bit_cast(v8i32, Bt_[n]), __builtin_bit_cast(v8i32, At[m]), acc[ai][bj][m][n], 0, 0, 0, 0x7c7c7c7c, 0, 0x7c7c7c7c);   \
        else { acc[ai][bj][m][n] = __builtin_amdgcn_mfma_f32_16x16x32_bf16(PG8_HALF(Bt_[n], 0), PG8_HALF(At[m], 0), acc[ai][bj][m][n], 0, 0, 0); \
               acc[ai][bj][m][n] = __builtin_amdgcn_mfma_f32_16x16x32_bf16(PG8_HALF(Bt_[n], 1), PG8_HALF(At[m], 1), acc[ai][bj][m][n], 0, 0, 0); } } \
        __builtin_amdgcn_s_setprio(0); } while (0)
#define PG8_WAIT_V(n) asm volatile("s_waitcnt vmcnt(" #n ")" ::: "memory")
#define PG8_WAIT_L(n) asm volatile("s_waitcnt lgkmcnt(" #n ")" ::: "memory")
#define PG8_BAR __builtin_amdgcn_s_barrier()
#define PG8_SCHED __builtin_amdgcn_sched_barrier(0)
#define PG8_GOFF(dst, u) do { if constexpr (GATHER) { _Pragma("unroll") for (int _h = 0; _h < 2; ++_h) _Pragma("unroll") for (int _i = 0; _i < 2; ++_i) \
        dst[_h * 2 + _i] = (unsigned)(gtab[(u).grow + _h * HALF + stR[_i]] * lda + stC[_i] * 2); } } while (0)
    Unit cur, nxt; int ui = 0;
    if (!S.next(0, cur)) return;
    f32x4 acc[2][2][4][2];
#pragma unroll
    for (int a = 0; a < 2; ++a)
#pragma unroll
        for (int b = 0; b < 2; ++b)
#pragma unroll
            for (int m = 0; m < 4; ++m)
#pragma unroll
                for (int n = 0; n < 2; ++n) acc[a][b][m][n] = (f32x4){0.f, 0.f, 0.f, 0.f};
    typedef unsigned v8u __attribute__((ext_vector_type(8)));
    v8u At[4], B0[2], B1[2];
    unsigned gC[4] = {0u, 0u, 0u, 0u}, gN[4] = {0u, 0u, 0u, 0u};
    const char* cA = (const char*)A + cur.aoff; const char* cB = (const char*)Bt + cur.boff;
    PG8_GOFF(gC, cur);
    PG8_STAGE(PG8_SB(0, 0), cB, voffB); PG8_STAGE(PG8_SB(0, 1), cB + hstepB, voffB); PG8_STAGE_A(PG8_SA(0, 0), cA, 0, gC); PG8_STAGE_A(PG8_SA(0, 1), cA, 1, gC);
    if (wr == 1) PG8_BAR;
    PG8_WAIT_V(2); PG8_BAR;
    PG8_STAGE(PG8_SB(1, 0), cB + kstep, voffB); PG8_STAGE_A(PG8_SA(1, 0), cA + kstep, 0, gC); PG8_STAGE(PG8_SB(1, 1), cB + hstepB + kstep, voffB);
    PG8_WAIT_V(6); PG8_BAR;
    for (;;) {
        const bool has_next = S.next(ui + 1, nxt);
        const char* nA = has_next ? (const char*)A + nxt.aoff : cA; const char* nB = has_next ? (const char*)Bt + nxt.boff : cB;
        if constexpr (GATHER) { if (has_next) { PG8_GOFF(gN, nxt); } else {
#pragma unroll
            for (int q = 0; q < 4; ++q) gN[q] = gC[q]; } }
#pragma unroll 1
        for (int t = 0; t < nt; t += 2) {
            const bool last = (t == nt - 2);
            const char* a1 = cA + (size_t)(t + 1) * kstep;
            const char* a2 = last ? nA : cA + (size_t)(t + 2) * kstep; const char* b2 = last ? nB : cB + (size_t)(t + 2) * kstep;
            const char* a3 = a2 + kstep; const char* b3 = b2 + kstep;
            PG8_LDB(B0, 0, 0); PG8_LDB(B1, 0, 1); PG8_SCHED; PG8_LDA(At, 0, 0); PG8_STAGE_A(PG8_SA(1, 1), a1, 1, gC);
            if constexpr (GATHER) { if (last) {
#pragma unroll
                for (int q = 0; q < 4; ++q) gC[q] = gN[q]; } }
            PG8_WAIT_V(8); PG8_WAIT_L(0); PG8_BAR; PG8_MMA(0, 0, At, B0); PG8_MMA(0, 1, At, B1); PG8_BAR; PG8_SCHED;
            PG8_LDA(At, 0, 1); PG8_STAGE(PG8_SB(0, 0), b2, voffB); PG8_STAGE(PG8_SB(0, 1), b2 + hstepB, voffB); PG8_STAGE_A(PG8_SA(0, 0), a2, 0, gC);
            PG8_WAIT_V(8); PG8_WAIT_L(0); PG8_BAR; PG8_MMA(1, 0, At, B0); PG8_MMA(1, 1, At, B1); PG8_BAR; PG8_SCHED;
            PG8_LDB(B0, 1, 0); PG8_LDB(B1, 1, 1); PG8_SCHED; PG8_LDA(At, 1, 0); PG8_STAGE_A(PG8_SA(0, 1), a2, 1, gC);
            PG8_WAIT_V(8); PG8_WAIT_L(0); PG8_BAR; PG8_MMA(0, 0, At, B0); PG8_MMA(0, 1, At, B1); PG8_BAR; PG8_SCHED;
            PG8_LDA(At, 1, 1); PG8_STAGE(PG8_SB(1, 0), b3, voffB); PG8_STAGE(PG8_SB(1, 1), b3 + hstepB, voffB); PG8_STAGE_A(PG8_SA(1, 0), a3, 0, gC);
            PG8_WAIT_V(8); PG8_WAIT_L(0); PG8_BAR; PG8_MMA(1, 0, At, B0); PG8_MMA(1, 1, At, B1); PG8_BAR; PG8_SCHED;
        }
        if (wr == 0) PG8_BAR;
        { const int le = fresh_lane(); E(acc, cur, wr, wc, le & 15, le >> 4); }
        if (!has_next) break;
#pragma unroll
        for (int a = 0; a < 2; ++a)
#pragma unroll
            for (int b = 0; b < 2; ++b)
#pragma unroll
                for (int m = 0; m < 4; ++m)
#pragma unroll
                    for (int n = 0; n < 2; ++n) acc[a][b][m][n] = (f32x4){0.f, 0.f, 0.f, 0.f};
        cur = nxt; cA = nA; cB = nB; ++ui;
        if (wr == 1) PG8_BAR;
    }
    PG8_WAIT_V(0);
    PG8_BAR;
#undef PG8_SA
#undef PG8_SB
#undef PG8_SBR
#undef PG8_STAGE
#undef PG8_STAGE_A
#undef PG8_LDA
#undef PG8_LDB
#undef PG8_MMA
#undef PG8_HALF
#undef PG8_LD16
#undef PG8_WAIT_V
#undef PG8_WAIT_L
#undef PG8_BAR
#undef PG8_SCHED
#undef PG8_GOFF
}
}

namespace pg8 {
DI v4u pack8(const f32x4& v0, const f32x4& v1) { v4u w; w.x = cvt_pk_bf16(v0[0], v0[1]); w.y = cvt_pk_bf16(v0[2], v0[3]); w.z = cvt_pk_bf16(v1[0], v1[1]); w.w = cvt_pk_bf16(v1[2], v1[3]); return w; }
DI void unpack8(const v4u w, f32x4& v0, f32x4& v1) { v0 = (f32x4){bf_lo(w.x), bf_hi(w.x), bf_lo(w.y), bf_hi(w.y)}; v1 = (f32x4){bf_lo(w.z), bf_hi(w.z), bf_lo(w.w), bf_hi(w.w)}; }

struct SchedA1 {
    int G, c; size_t esz;
    DI bool next(int i, Unit& u) const {
        const long L = (long)i * G + c; const int n1 = 132 * 12, n2 = 132 * 2, n3 = 128 * 4;
        if (L >= n1 + n2 + n3) return false;
        int pm, pn;
        if (L < n1) { tile_order((int)L, 132, 12, pm, pn); pn += 4; }
        else if (L < n1 + n2) { tile_order((int)L - n1, 132, 2, pm, pn); pn += 28; }
        else { int pl; tile_order((int)L - n1 - n2, 128, 4, pl, pn); pm = (pl >> 5) * TPB + 1 + (pl & 31); }
        u.pm = pm; u.pn = pn; u.aoff = (size_t)pm * 256 * DM * esz; u.boff = (size_t)pn * 256 * DM * esz; u.grow = 0; return true;
    }
};
struct EpiA1 {
    static constexpr bool PERM = true;
    bf16 *QR, *KR, *VR, *KA, *VA; const float *cosr, *sinr;
    DI void operator()(const f32x4 (&acc)[2][2][4][2], const Unit& u, int wr, int wc, int fr, int fq) const {
        const int pn = u.pn; const int tin = u.pm % TPB;
        if (pn >= 8) {
            const int ldc = pn >= 28 ? 256 : 2048;
            bf16* base = (pn == 28 ? KA : (pn == 29 ? VA : VR + (pn - 8) * 256)) + (size_t)(u.pm * 256 + wr * 64 + fr) * ldc + wc * 32 + 8 * fq;
#pragma unroll
            for (int ai = 0; ai < 2; ++ai)
#pragma unroll
                for (int m = 0; m < 4; ++m)
#pragma unroll
                    for (int bj = 0; bj < 2; ++bj) __builtin_nontemporal_store(pack8(acc[ai][bj][m][0], acc[ai][bj][m][1]), (v4u*)(base + (size_t)(ai * 128 + m * 16) * ldc + bj * 128));
            return;
        }
        const bool isk = pn >= 4; const float sc = isk ? 0.0625f : 1.0f; const bool rope = tin != 0;
        const int hd = pn & 3, R0 = u.pm * 256 + wr * 64 + fr;
        const int axis = wc >> 1, f0 = 32 * (wc & 1) + 8 * fq;
#pragma unroll
        for (int ai = 0; ai < 2; ++ai)
#pragma unroll
            for (int m = 0; m < 4; ++m) {
                f32x4 o1[2], o2[2];
                if (rope) {
                    const int t = (tin - 1) * 256 + ai * 128 + wr * 64 + m * 16 + fr;
                    const int pos = axis ? (t & 63) : (t >> 6);
#pragma unroll
                    for (int n = 0; n < 2; ++n) {
                        const f32x4 cs = *(const f32x4*)(cosr + pos * 64 + f0 + 4 * n), sn = *(const f32x4*)(sinr + pos * 64 + f0 + 4 * n);
                        const f32x4 x1 = acc[ai][0][m][n], x2 = acc[ai][1][m][n];
                        o1[n] = (x1 * cs - x2 * sn) * sc; o2[n] = (x2 * cs + x1 * sn) * sc;
                    }
                } else {
#pragma unroll
                    for (int n = 0; n < 2; ++n) { o1[n] = acc[ai][0][m][n] * sc; o2[n] = acc[ai][1][m][n] * sc; }
                }
                const int R = R0 + ai * 128 + m * 16;
                if (isk) { bf16* rp = KR + ((size_t)((R >> 6) * 4 + hd) * 2) * 8192 + ((4 * wc + fq) * 64 + (R & 63)) * 8;
                    __builtin_nontemporal_store(pack8(o1[0], o1[1]), (v4u*)(rp)); __builtin_nontemporal_store(pack8(o2[0], o2[1]), (v4u*)(rp + 8192)); }
                else { bf16* rp = QR + (size_t)((R >> 5) * 4 + hd) * 8192 + ((2 * wc + (fq >> 1)) * 64 + (fq & 1) * 32 + (R & 31)) * 8;
                    __builtin_nontemporal_store(pack8(o1[0], o1[1]), (v4u*)(rp)); __builtin_nontemporal_store(pack8(o2[0], o2[1]), (v4u*)(rp + 8 * 64 * 8)); }
            }
    }
};

struct SchedB1 {
    int G, c; size_t esz;
    DI bool next(int i, Unit& u) const {
        const long L = (long)i * G + c; const int n1 = 128 * 20;
        if (L >= n1) return false;
        int pm, pn;
        { int pl; tile_order((int)L, 128, 20, pl, pn); pm = (pl >> 5) * TPB + 1 + (pl & 31); if (pn >= 12) pn += 2; }
        u.pm = pm; u.pn = pn; u.aoff = (size_t)pm * 256 * DM * esz; u.boff = (size_t)pn * 256 * DM * esz; u.grow = 0; return true;
    }
};
DI size_t gt_frag_off(int pm, int pnl, int wr, int wc, int fr, int fq) { return ((size_t)((pm * 4 + pnl) * 8 + wr * 4 + wc) * 16) * 512 + (size_t)(fq * 16 + fr) * 8; }
struct EpiB1 {
    static constexpr bool PERM = true;
    bf16 *GR, *QA, *KA, *VA, *GTR, *GTA;
    DI void operator()(const f32x4 (&acc)[2][2][4][2], const Unit& u, int wr, int wc, int fr, int fq) const {
        const int pn = u.pn; bf16* dst; int ldc, col0, act;
        if (pn < 8) { dst = GR; ldc = 2048; col0 = pn * 256; act = 1; }
        else if (pn < 12) { dst = QA; ldc = 1024; col0 = (pn - 8) * 256; act = 0; }
        else if (pn == 12) { dst = KA; ldc = 256; col0 = 0; act = 0; }
        else if (pn == 13) { dst = VA; ldc = 256; col0 = 0; act = 0; }
        else if (pn < 18) { dst = GTR; ldc = 1024; col0 = (pn - 14) * 256; act = 2; }
        else { dst = GTA; ldc = 1024; col0 = (pn - 18) * 256; act = 2; }
        bf16* base = dst + (size_t)(u.pm * 256 + wr * 64 + fr) * ldc + col0 + wc * 32 + 8 * fq;
#pragma unroll
        for (int ai = 0; ai < 2; ++ai)
#pragma unroll
            for (int m = 0; m < 4; ++m)
#pragma unroll
                for (int bj = 0; bj < 2; ++bj) {
                    f32x4 v0 = acc[ai][bj][m][0], v1 = acc[ai][bj][m][1];
                    if (act) {
#pragma unroll
                        for (int j = 0; j < 4; ++j) { const float s0 = fast_sigmoid(v0[j]), s1 = fast_sigmoid(v1[j]); v0[j] = act == 1 ? v0[j] * s0 : s0; v1[j] = act == 1 ? v1[j] * s1 : s1; }
                    }
                    if (act == 2) { v2u q; q.x = pk4_fp8(v0[0], v0[1], v0[2], v0[3]); q.y = pk4_fp8(v1[0], v1[1], v1[2], v1[3]);
                        __builtin_nontemporal_store(q, (v2u*)((unsigned char*)dst + gt_frag_off(u.pm, (pn - 14) & 3, wr, wc, fr, fq) + (size_t)(ai * 8 + m * 2 + bj) * 512)); }
                    else __builtin_nontemporal_store(pack8(v0, v1), (v4u*)(base + (size_t)(ai * 128 + m * 16) * ldc + bj * 128));
                }
    }
};

struct SchedLat {
    int G, c, lda, ldb;
    DI bool next(int i, Unit& u) const {
        const long L = (long)i * G + c; if (L >= 128 * 4) return false;
        int pl, pn; tile_order((int)L, 128, 4, pl, pn); const int pm = (pl >> 5) * TPB + 1 + (pl & 31);
        u.pm = pm; u.pn = pn; u.aoff = (size_t)pm * 256 * lda; u.boff = (size_t)pn * 256 * ldb; u.grow = pl; return true;
    }
};
template <bool ADD> struct EpiGate {
    static constexpr bool PERM = true;
    bf16* Y; const unsigned char* Gt; unsigned char* Y8;
    DI void operator()(const f32x4 (&acc)[2][2][4][2], const Unit& u, int wr, int wc, int fr, int fq) const {
        const size_t off0 = (size_t)(u.pm * 256 + wr * 64 + fr) * 1024 + u.pn * 256 + wc * 32 + 8 * fq, goff0 = gt_frag_off(u.pm, u.pn, wr, wc, fr, fq);
#pragma unroll
        for (int ai = 0; ai < 2; ++ai) {
            v2u gq[4][2]; v4u yq[4][2];
#pragma unroll
            for (int m = 0; m < 4; ++m)
#pragma unroll
                for (int bj = 0; bj < 2; ++bj) { const size_t off = off0 + (size_t)(ai * 128 + m * 16) * 1024 + bj * 128; gq[m][bj] = *(const v2u*)(Gt + goff0 + (size_t)(ai * 8 + m * 2 + bj) * 512); if (ADD) yq[m][bj] = *(const v4u*)(Y + goff0 + (size_t)(ai * 8 + m * 2 + bj) * 512); }
#pragma unroll
            for (int m = 0; m < 4; ++m)
#pragma unroll
                for (int bj = 0; bj < 2; ++bj) {
                    const size_t off = off0 + (size_t)(ai * 128 + m * 16) * 1024 + bj * 128;
                    f32x4 g0, g1; { const auto l0 = __builtin_amdgcn_cvt_pk_f32_fp8((int)gq[m][bj].x, false), h0 = __builtin_amdgcn_cvt_pk_f32_fp8((int)gq[m][bj].x, true), l1 = __builtin_amdgcn_cvt_pk_f32_fp8((int)gq[m][bj].y, false), h1 = __builtin_amdgcn_cvt_pk_f32_fp8((int)gq[m][bj].y, true);
                        g0 = (f32x4){l0[0], l0[1], h0[0], h0[1]}; g1 = (f32x4){l1[0], l1[1], h1[0], h1[1]}; }
                    f32x4 v0 = acc[ai][bj][m][0] * g0, v1 = acc[ai][bj][m][1] * g1;
                    if (ADD) { f32x4 y0, y1; unpack8(yq[m][bj], y0, y1); v0 = (v0 + y0) * 4.0f; v1 = (v1 + y1) * 4.0f; v2u q;
#define YQ(v) __builtin_amdgcn_fmed3f((v), -448.f, 448.f)
                        q.x = pk4_fp8(YQ(v0[0]), YQ(v0[1]), YQ(v0[2]), YQ(v0[3])); q.y = pk4_fp8(YQ(v1[0]), YQ(v1[1]), YQ(v1[2]), YQ(v1[3]));
#undef YQ
                        *(v2u*)(Y8 + off) = q; }
                    else *(v4u*)(Y + goff0 + (size_t)(ai * 8 + m * 2 + bj) * 512) = pack8(v0, v1);
                }
            asm volatile("" ::: "memory");
        }
    }
};
struct EpiOut {
    static constexpr bool PERM = true;
    const float* x; float* out; const float* mod; int half;
    DI void operator()(const f32x4 (&acc)[2][2][4][2], const Unit& u, int wr, int wc, int fr, int fq) const {
        const int pl = u.grow, b = half * NBH + (pl >> 5); const size_t tok0 = (size_t)b * SEQ + (size_t)(pl & 31) * 256 + wr * 64 + fr;
        const int col0 = u.pn * 256 + wc * 32 + 8 * fq; const float* g1 = mod + (size_t)b * 6144 + 2048 + col0;
        f32x4 gv[2][2];
#pragma unroll
        for (int bj = 0; bj < 2; ++bj)
#pragma unroll
            for (int n = 0; n < 2; ++n) gv[bj][n] = *(const f32x4*)(g1 + bj * 128 + n * 4);
#pragma unroll
        for (int ai = 0; ai < 2; ++ai)
#pragma unroll
            for (int mp = 0; mp < 2; ++mp) {
                f32x4 xq[2][2][2];
#pragma unroll
                for (int mm = 0; mm < 2; ++mm) { const size_t off = (tok0 + ai * 128 + (2 * mp + mm) * 16) * DM + col0;
#pragma unroll
                    for (int bj = 0; bj < 2; ++bj)
#pragma unroll
                        for (int n = 0; n < 2; ++n) xq[mm][bj][n] = __builtin_nontemporal_load((const f32x4*)(x + off + bj * 128 + n * 4)); }
#pragma unroll
                for (int mm = 0; mm < 2; ++mm) { const int m = 2 * mp + mm; bf16* xb = (bf16*)(out + (tok0 + ai * 128 + m * 16) * DM) + col0;
#pragma unroll
                    for (int bj = 0; bj < 2; ++bj)
                        *(v4u*)(xb + bj * 128) = pack8(xq[mm][bj][0] + gv[bj][0] * acc[ai][bj][m][0], xq[mm][bj][1] + gv[bj][1] * acc[ai][bj][m][1]); }
                asm volatile("" ::: "memory"); }
    }
};

struct SchedMoe {
    int G, c, ncol; const int* tileb; size_t b_exp_stride  , ldb  , lda  ; bool gather;
    DI bool next(int i, Unit& u) const {
        const int ntile = tileb[32]; const long L = (long)i * G + c; if (L >= (long)ntile * ncol) return false;
        const int rt = (int)(L / ncol), pn = (int)(L % ncol); const int e = tileb[64 + rt];
        u.pm = rt; u.pn = pn; u.grow = rt * 256; u.aoff = gather ? 0 : (size_t)rt * 256 * lda; u.boff = (size_t)e * b_exp_stride + (size_t)pn * 256 * ldb; return true;
    }
};
DI int moe_expert_of_tile(const int* tileb, int rt) { return tileb[64 + rt]; }
struct EpiSwiglu {
    static constexpr bool PERM = true;
    unsigned char* ACT; const float* b1; const int* tileb;
    DI void operator()(const f32x4 (&acc)[2][2][4][2], const Unit& u, int wr, int wc, int fr, int fq) const {
        const int e = moe_expert_of_tile(tileb, u.pm); const int cg = u.pn * 128 + wc * 32 + 8 * fq;
        const float* bp = b1 + (size_t)e * 2048 + cg;
        const f32x4 bg0 = *(const f32x4*)(bp), bg1 = *(const f32x4*)(bp + 4), bu0 = *(const f32x4*)(bp + 1024), bu1 = *(const f32x4*)(bp + 1028);
        unsigned char* base = ACT + (size_t)(u.pm * 256 + wr * 64 + fr) * 1024 + cg;
#pragma unroll
        for (int ai = 0; ai < 2; ++ai)
#pragma unroll
            for (int m = 0; m < 4; ++m) {
                f32x4 g0 = acc[ai][0][m][0] + bg0, g1 = acc[ai][0][m][1] + bg1, u0 = acc[ai][1][m][0] + bu0, u1 = acc[ai][1][m][1] + bu1;
#pragma unroll
                for (int j = 0; j < 4; ++j) {
                    const float ga = fminf(g0[j], 7.0f), gb = fminf(g1[j], 7.0f);
                    const float ua = fminf(fmaxf(u0[j], -7.0f), 7.0f), ub = fminf(fmaxf(u1[j], -7.0f), 7.0f);
                    g0[j] = 4.0f * ga * fast_sigmoid(1.702f * ga) * (ua + 1.0f); g1[j] = 4.0f * gb * fast_sigmoid(1.702f * gb) * (ub + 1.0f);
                }
                v2u w; w.x = pk4_fp8(g0[0], g0[1], g0[2], g0[3]); w.y = pk4_fp8(g1[0], g1[1], g1[2], g1[3]);
                __builtin_nontemporal_store(w, (v2u*)(base + (size_t)(ai * 128 + m * 16) * 1024));
                asm volatile("" ::: "memory");
            }
    }
};
struct EpiDown {
    static constexpr bool PERM = true;
    bf16* Y2; const float* b2; const int* tileb; const float* roww;
    DI void operator()(const f32x4 (&acc)[2][2][4][2], const Unit& u, int wr, int wc, int fr, int fq) const {
        const int e = moe_expert_of_tile(tileb, u.pm); const int c0 = u.pn * 256 + wc * 32 + 8 * fq;
        f32x4 bv[2][2];
#pragma unroll
        for (int bj = 0; bj < 2; ++bj)
#pragma unroll
            for (int n = 0; n < 2; ++n) bv[bj][n] = *(const f32x4*)(b2 + (size_t)e * 1024 + c0 + bj * 128 + 4 * n);
        float wq[2][4];
#pragma unroll
        for (int ai = 0; ai < 2; ++ai)
#pragma unroll
            for (int m = 0; m < 4; ++m) wq[ai][m] = roww[u.pm * 256 + ai * 128 + wr * 64 + m * 16 + fr];
        bf16* base = Y2 + (size_t)(u.pm * 256 + wr * 64 + fr) * 1024 + c0;
#pragma unroll
        for (int ai = 0; ai < 2; ++ai)
#pragma unroll
            for (int m = 0; m < 4; ++m) { const float w = wq[ai][m];
#pragma unroll
                for (int bj = 0; bj < 2; ++bj) __builtin_nontemporal_store(pack8((acc[ai][bj][m][0] + bv[bj][0]) * w, (acc[ai][bj][m][1] + bv[bj][1]) * w), (v4u*)(base + (size_t)(ai * 128 + m * 16) * 1024 + bj * 128));
            }
    }
};
}

namespace att {
constexpr int D = 128, NW = 8, QBLK = 32, KVBLK = 64;
constexpr float SCALE = 0.088388347648318440f;
constexpr float THR = 1.9f;
constexpr float PSH = 6.f;
constexpr float QSC = SCALE * 1.4426950408889634f;
constexpr float THR2 = THR * 1.4426950408889634f;
constexpr float VSC = 8.f;
constexpr int LDQ = 1024, LDK = 256, LDO = 1024;
constexpr size_t SHM_V = KVBLK * D, SHM_K = KVBLK * D, SLOT = SHM_K + SHM_V, SHM_ATTN = 8 * SLOT;
typedef int v8i32 __attribute__((ext_vector_type(8)));
#define KSWZ(row, colB) ((row) * 128 + ((colB) ^ ((((row) >> 1) & 7) << 4)))
#define SBAR() __builtin_amdgcn_sched_barrier(0)
DI int crow(int r, int hi) { return (r & 3) + 8 * (r >> 2) + 4 * hi; }
DI unsigned cvtpk(float lo, float hi) { unsigned r; asm volatile("v_cvt_pk_bf16_f32 %0, %1, %2" : "=v"(r) : "v"(lo), "v"(hi)); return r; }

DI void head_tile0(f32x16& p0, f32x16& p1, f32x16& nm, const char* Ks, const v8i32* qf, int r32, int hi) {
  p0 = f32x16{}; p1 = f32x16{};
#pragma unroll
  for (int c = 0; c < 2; ++c) { const int cb = c * 64 + hi * 32;
    const v4u a0 = *reinterpret_cast<const v4u*>(Ks + KSWZ(r32, cb)), a1 = *reinterpret_cast<const v4u*>(Ks + KSWZ(r32, cb + 16));
    const v4u b0 = *reinterpret_cast<const v4u*>(Ks + KSWZ(32 + r32, cb)), b1 = *reinterpret_cast<const v4u*>(Ks + KSWZ(32 + r32, cb + 16));
    const v8i32 ka = {(int)a0.x, (int)a0.y, (int)a0.z, (int)a0.w, (int)a1.x, (int)a1.y, (int)a1.z, (int)a1.w};
    const v8i32 kb = {(int)b0.x, (int)b0.y, (int)b0.z, (int)b0.w, (int)b1.x, (int)b1.y, (int)b1.z, (int)b1.w};
    p0 = __builtin_amdgcn_mfma_scale_f32_32x32x64_f8f6f4(ka, qf[c], p0, 0, 0, 0, 0, 0, 0);
    p1 = __builtin_amdgcn_mfma_scale_f32_32x32x64_f8f6f4(kb, qf[c], p1, 0, 0, 0, 0, 0, 0); }
  float pmax = p0[0]; for (int r = 1; r < 16; ++r) pmax = fmaxf(pmax, p0[r]); for (int r = 0; r < 16; ++r) pmax = fmaxf(pmax, p1[r]);
  { auto rr = __builtin_amdgcn_permlane32_swap(__float_as_uint(pmax), __float_as_uint(pmax), false, false);
    pmax = fmaxf(__uint_as_float(rr[0]), __uint_as_float(rr[1])); }
  const float nmv = PSH - pmax;
  for (int r = 0; r < 16; ++r) { nm[r] = nmv; p0[r] = __builtin_amdgcn_exp2f(p0[r] + nmv); p1[r] += nmv; }
}
DI void finishSM(f32x16& p0, f32x16& p1, v8i32& pb) {
  for (int r = 0; r < 16; ++r) p1[r] = __builtin_amdgcn_exp2f(p1[r]);
#pragma unroll
  for (int w = 0; w < 4; ++w) { pb[w] = (int)pk4_fp8(p0[4 * w], p0[4 * w + 1], p0[4 * w + 2], p0[4 * w + 3]); pb[4 + w] = (int)pk4_fp8(p1[4 * w], p1[4 * w + 1], p1[4 * w + 2], p1[4 * w + 3]); }
}
DI void pv8(f32x16* o, const char* Vs, int va, const v8i32& pb) {
#pragma unroll
  for (int db = 0; db < 4; ++db) {
    const v4u x0 = *reinterpret_cast<const v4u*>(Vs + db * 2048 + va), x1 = *reinterpret_cast<const v4u*>(Vs + db * 2048 + (va ^ 16));
    const v8i32 vt = {(int)x0.x, (int)x0.y, (int)x0.z, (int)x0.w, (int)x1.x, (int)x1.y, (int)x1.z, (int)x1.w};
    o[db] = __builtin_amdgcn_mfma_scale_f32_32x32x64_f8f6f4(vt, pb, o[db], 0, 0, 0, 0, 0, 0); }
}

DI v8i32 krd(const char* Ks, int row, int cb) { const v4u a = *reinterpret_cast<const v4u*>(Ks + KSWZ(row, cb)), b = *reinterpret_cast<const v4u*>(Ks + KSWZ(row, cb + 16));
  return v8i32{(int)a.x, (int)a.y, (int)a.z, (int)a.w, (int)b.x, (int)b.y, (int)b.z, (int)b.w}; }
DI v8i32 vrd(const char* Vs, int db, int va) { const v4u a = *reinterpret_cast<const v4u*>(Vs + db * 2048 + va), b = *reinterpret_cast<const v4u*>(Vs + db * 2048 + (va ^ 16));
  return v8i32{(int)a.x, (int)a.y, (int)a.z, (int)a.w, (int)b.x, (int)b.y, (int)b.z, (int)b.w}; }
#define MF8(a, b, c) __builtin_amdgcn_mfma_scale_f32_32x32x64_f8f6f4(a, b, c, 0, 0, 0, 0, 0, 0)
DI v8i32 mkones() { v8i32 o; for (int w = 0; w < 8; ++w) { int x_; asm volatile("v_mov_b32 %0, 0x38383838" : "=v"(x_)); o[w] = x_; } return o; }
#ifdef DIAG_ATT
#define ATT_ONES mkones()
#else
#define ATT_ONES ones
#endif
#define ANCH(x) asm volatile("" : "+v"(x))
#define MFS(a, b, c) __builtin_amdgcn_mfma_scale_f32_32x32x64_f8f6f4(a, b, c, 0, 0, 0, 0, 0, 0)
#define PKC(dst, P, w) do { int t_ = __builtin_amdgcn_cvt_pk_fp8_f32(P[4 * (w)], P[4 * (w) + 1], dst, false); dst = __builtin_amdgcn_cvt_pk_fp8_f32(P[4 * (w) + 2], P[4 * (w) + 3], t_, true); } while (0)
#define ATT_STEP(pC0, pC1, alC, pN0, pN1, alN, KB, VB) do {                                                                                            \
    SBAR(); const v8i32 k0_ = krd(KB, r32, hi * 32), k1_ = krd(KB, 32 + r32, hi * 32);                                                                  \
    SBAR(); pN0 = MFS(k0_, qf[0], nm);                                                                                                                  \
    SBAR(); for (int r = 0; r < 8; ++r) pC1[r] = __builtin_amdgcn_exp2f(pC1[r]);                                                                       \
    const v8i32 k2_ = krd(KB, r32, 64 + hi * 32), k3_ = krd(KB, 32 + r32, 64 + hi * 32); ANCH(pC1);                                                     \
    SBAR(); pN1 = MFS(k1_, qf[0], nm);                                                                                                                  \
    SBAR(); for (int r = 8; r < 16; ++r) pC1[r] = __builtin_amdgcn_exp2f(pC1[r]); ANCH(pC1);                                                           \
    SBAR(); pN0 = MFS(k2_, qf[1], pN0);                                                                                                                 \
    SBAR(); PKC(pb[0], pC0, 0); PKC(pb[1], pC0, 1); PKC(pb[2], pC0, 2); PKC(pb[3], pC0, 3);                                                                     \
    SBAR(); pN1 = MFS(k3_, qf[1], pN1);                                                                                                                 \
    SBAR(); PKC(pb[4], pC1, 0); PKC(pb[5], pC1, 1); PKC(pb[6], pC1, 2); PKC(pb[7], pC1, 3);                                                                     \
    const v8i32 v0_ = vrd(VB, 0, va), v1_ = vrd(VB, 1, va);                                                                                             \
    SBAR(); o[0] = MF8(v0_, pb, o[0]);                                                                                                                  \
    SBAR(); pC0 = MF8(ATT_ONES, pb, f32x16{});     \
    SBAR(); float pm_ = fmaxf(pN0[0], pN1[0]); for (int r = 1; r < 16; ++r) pm_ = fmaxf(fmaxf(pm_, pN0[r]), pN1[r]);                                   \
    { auto rr = __builtin_amdgcn_permlane32_swap(__float_as_uint(pm_), __float_as_uint(pm_), false, false); pm_ = fmaxf(__uint_as_float(rr[0]), __uint_as_float(rr[1])); } \
    const v8i32 v2_ = vrd(VB, 2, va), v3_ = vrd(VB, 3, va); alN = 1.f;                                                                                  \
    if (__builtin_expect(!__all(pm_ - PSH <= THR2), 0)) { const float dl_ = fmaxf(pm_ - PSH, 0.f); alN = __builtin_amdgcn_exp2f(-dl_);                  \
      for (int r = 0; r < 16; ++r) { pN0[r] -= dl_; pN1[r] -= dl_; nm[r] -= dl_; } }                                                                    \
    SBAR(); o[1] = MF8(v1_, pb, o[1]);                                                                                                                  \
    SBAR(); for (int r = 0; r < 8; ++r) pN0[r] = __builtin_amdgcn_exp2f(pN0[r]); ANCH(pN0);                                                            \
    SBAR(); o[2] = MF8(v2_, pb, o[2]);                                                                                                                  \
    SBAR(); for (int r = 8; r < 16; ++r) pN0[r] = __builtin_amdgcn_exp2f(pN0[r]); ANCH(pN0);                                                           \
    SBAR(); o[3] = MF8(v3_, pb, o[3]);                                                                                                                  \
    SBAR(); l_reg = l_reg * alC + pC0[0]; ANCH(l_reg);                                                                                                  \
    SBAR(); } while (0)

DI void attn_dense_body(const bf16* Qb, const unsigned char* __restrict__ K8h, const unsigned char* __restrict__ V8h, bf16* Ob, unsigned char* O8b, int seq, LAS unsigned char* ldsl,
                        int tpos0, const float* __restrict__ qn, const float* __restrict__ cosa, const float* __restrict__ sina) {
  const int tid = opaque_tid(), wid = tid >> 6, lane = tid & 63, r32 = lane & 31, hi = lane >> 5;
  const char* lds = (const char*)ldsl;
  f32x16 o[4] = {}; f32x16 nm; v8i32 qf[2]; float l_reg = 0.f;
  v8i32 ones;
#pragma unroll
  for (int w = 0; w < 8; ++w) { int x_; asm volatile("v_mov_b32 %0, 0x38383838" : "=v"(x_)); ones[w] = x_; }
  char* const ldsw = (char*)ldsl;
  v4u st_k, st_v;
#define SLOAD(t_) do { st_k = *reinterpret_cast<const v4u*>(K8h + (long)(t_) * 8192 + tid * 16); st_v = *reinterpret_cast<const v4u*>(V8h + (long)(t_) * 8192 + tid * 16); } while (0)
#define SWRITE(t_) do { *reinterpret_cast<v4u*>(ldsw + ((t_) & 7) * (int)SLOT + tid * 16) = st_k; *reinterpret_cast<v4u*>(ldsw + ((t_) & 7) * (int)SLOT + (int)SHM_K + tid * 16) = st_v; } while (0)
  const v4u pk0_ = *reinterpret_cast<const v4u*>(K8h + tid * 16), pv0_ = *reinterpret_cast<const v4u*>(V8h + tid * 16);
  const v4u pk1_ = *reinterpret_cast<const v4u*>(K8h + 8192 + tid * 16), pv1_ = *reinterpret_cast<const v4u*>(V8h + 8192 + tid * 16);
  SLOAD(2);
  {
    const bf16* Qw = Qb + (long)(wid * QBLK + r32) * LDQ;
    float ss = 0.f;
#pragma unroll
    for (int d0 = 0; d0 < 8; ++d0) { const v4u w = *reinterpret_cast<const v4u*>(Qw + d0 * 16 + hi * 8);
      const float a0 = bf_lo(w.x), a1 = bf_hi(w.x), a2 = bf_lo(w.y), a3 = bf_hi(w.y), a4 = bf_lo(w.z), a5 = bf_hi(w.z), a6 = bf_lo(w.w), a7 = bf_hi(w.w);
      ss += (a0 * a0 + a1 * a1) + (a2 * a2 + a3 * a3) + (a4 * a4 + a5 * a5) + (a6 * a6 + a7 * a7); }
    { auto rr = __builtin_amdgcn_permlane32_swap(__float_as_uint(ss), __float_as_uint(ss), false, false); ss = __uint_as_float(rr[0]) + __uint_as_float(rr[1]); }
    const float rstd = 1.0f / sqrtf(ss * (1.0f / 128.0f) + EPS);
    const int t = tpos0 + wid * QBLK + r32;
#pragma unroll
    for (int a = 0; a < 2; ++a) { const int pos = a ? (t & 63) : (t >> 6);
#pragma unroll
      for (int g = 0; g < 4; ++g) {
        const v4u wa = *reinterpret_cast<const v4u*>(Qw + 64 * a + 8 * g), wb = *reinterpret_cast<const v4u*>(Qw + 64 * a + 32 + 8 * g);
        float x1[8] = {bf_lo(wa.x), bf_hi(wa.x), bf_lo(wa.y), bf_hi(wa.y), bf_lo(wa.z), bf_hi(wa.z), bf_lo(wa.w), bf_hi(wa.w)};
        float x2[8] = {bf_lo(wb.x), bf_hi(wb.x), bf_lo(wb.y), bf_hi(wb.y), bf_lo(wb.z), bf_hi(wb.z), bf_lo(wb.w), bf_hi(wb.w)};
        float oo[8];
#pragma unroll
        for (int j = 0; j < 8; ++j) { const float g1 = qn[64 * a + 8 * g + j] * rstd, g2 = qn[64 * a + 32 + 8 * g + j] * rstd; const float cs = cosa[pos * 32 + 8 * g + j], sn = sina[pos * 32 + 8 * g + j];
          const float y1 = x1[j] * g1, y2 = x2[j] * g2; const float v = hi ? (y2 * cs + y1 * sn) : (y1 * cs - y2 * sn); oo[j] = __builtin_amdgcn_fmed3f(v * QSC, -448.f, 448.f); }
        qf[a][2 * g] = (int)pk4_fp8(oo[0], oo[1], oo[2], oo[3]); qf[a][2 * g + 1] = (int)pk4_fp8(oo[4], oo[5], oo[6], oo[7]); } }
  }
  const int va = r32 * 64 + (((2 * hi) ^ ((r32 >> 2) & 3)) << 4);
#define RESC(a) do { if (__any((a) < 1.f)) { for (int d = 0; d < 4; ++d) for (int r = 0; r < 16; ++r) o[d][r] *= (a); } } while (0)
#define KSLOT(t_) (lds + ((t_) & 7) * (int)SLOT)
#define VSLOT(t_) (lds + ((t_) & 7) * (int)SLOT + (int)SHM_K)
  f32x16 pA0, pA1, pB0, pB1; float alA = 1.f, alB; v8i32 pb = {0, 0, 0, 0, 0, 0, 0, 0}; const int NT = seq / KVBLK;
  *reinterpret_cast<v4u*>(ldsw + tid * 16) = pk0_; *reinterpret_cast<v4u*>(ldsw + (int)SHM_K + tid * 16) = pv0_;
  *reinterpret_cast<v4u*>(ldsw + (int)SLOT + tid * 16) = pk1_; *reinterpret_cast<v4u*>(ldsw + (int)SLOT + (int)SHM_K + tid * 16) = pv1_;
  SWRITE(2); __syncthreads();
  head_tile0(pA0, pA1, nm, KSLOT(0), qf, r32, hi);
  for (int t = 0; t + 2 < NT; t += 2) {
    if (t + 3 < NT) SLOAD(t + 3); RESC(alA);
    ATT_STEP(pA0, pA1, alA, pB0, pB1, alB, KSLOT(t + 1), VSLOT(t));
    if (t + 3 < NT) SWRITE(t + 3);
    if (t + 4 < NT) SLOAD(t + 4); RESC(alB);
    ATT_STEP(pB0, pB1, alB, pA0, pA1, alA, KSLOT(t + 2), VSLOT(t + 1));
    if (t + 4 < NT) SWRITE(t + 4); __syncthreads();
  }
  RESC(alA);
  ATT_STEP(pA0, pA1, alA, pB0, pB1, alB, KSLOT(NT - 1), VSLOT(NT - 2));
  RESC(alB);
  finishSM(pB0, pB1, pb); SBAR();
  pv8(o, VSLOT(NT - 1), va, pb); pB0 = MF8(ATT_ONES, pb, f32x16{}); l_reg = l_reg * alB + pB0[0];
  const float rl = __builtin_amdgcn_rcpf(l_reg) * (1.0f / VSC);
  const int tid2 = opaque_tid();
#ifdef DIAG_ATT
  bf16* Ow = Ob + (long)((tid2 >> 6) * QBLK + (tid2 & 31)) * LDO + 4 * ((tid2 >> 5) & 1);
#pragma unroll
  for (int db = 0; db < 4; ++db)
#pragma unroll
    for (int r4 = 0; r4 < 4; ++r4) { v2u w; w.x = cvtpk(o[db][4 * r4] * rl, o[db][4 * r4 + 1] * rl); w.y = cvtpk(o[db][4 * r4 + 2] * rl, o[db][4 * r4 + 3] * rl);
      *reinterpret_cast<v2u*>(Ow + 32 * db + 8 * r4) = w; }
#else
  unsigned char* Ow = O8b + (long)((tid2 >> 6) * QBLK + (tid2 & 31)) * LDO + 4 * ((tid2 >> 5) & 1);
  const float rl4 = rl * 4.0f;
#pragma unroll
  for (int db = 0; db < 4; ++db)
#pragma unroll
    for (int r4 = 0; r4 < 4; ++r4)
      *reinterpret_cast<unsigned*>(Ow + 32 * db + 8 * r4) = pk4_fp8(__builtin_amdgcn_fmed3f(o[db][4 * r4] * rl4, -448.f, 448.f), __builtin_amdgcn_fmed3f(o[db][4 * r4 + 1] * rl4, -448.f, 448.f),
                                                                  __builtin_amdgcn_fmed3f(o[db][4 * r4 + 2] * rl4, -448.f, 448.f), __builtin_amdgcn_fmed3f(o[db][4 * r4 + 3] * rl4, -448.f, 448.f));
  (void)Ob;
#endif
  __syncthreads();
#undef SLOAD
#undef SWRITE
#undef KSLOT
#undef VSLOT
#undef RESC
}
#undef ATT_STEP
#undef MFS
#undef PKC
#undef ANCH
#undef MF8
#undef KSWZ
}
namespace ret {
constexpr int C = 128;
constexpr int KP = 1088, KTILE = 16 * KP, VP = 2112;
constexpr int VIMG = 8 * VP;
constexpr int KT_OFF = 0, V_OFF = 4 * KTILE, ST_OFF = V_OFF + 2 * VIMG, P_OFF = ST_OFF + 2 * KTILE, RET_LDS = P_OFF + 10 * 2048;
DI int crow(int r, int hi) { return (r & 3) + 8 * (r >> 2) + 4 * hi; }
typedef short v4i16_t __attribute__((ext_vector_type(4)));
DI s16x4 vtr(unsigned addr) { return __builtin_bit_cast(s16x4, __builtin_amdgcn_ds_read_tr16_b64_v4i16((LAS v4i16_t*)addr)); }
DI bf16x8 cat8(s16x4 l, s16x4 h) { return (bf16x8){l[0], l[1], l[2], l[3], h[0], h[1], h[2], h[3]}; }
DI bf16x8 ldsr(unsigned addr) { return *(const LAS bf16x8*)(uintptr_t)addr; }
#define RPK4(P, BASE, OUT) do { unsigned a0 = cvt_pk_bf16(P[BASE + 0], P[BASE + 1]), a1 = cvt_pk_bf16(P[BASE + 2], P[BASE + 3]);   \
    unsigned b0 = cvt_pk_bf16(P[BASE + 4], P[BASE + 5]), b1 = cvt_pk_bf16(P[BASE + 6], P[BASE + 7]);                              \
    auto r0 = __builtin_amdgcn_permlane32_swap(a0, b0, false, false); auto r1 = __builtin_amdgcn_permlane32_swap(a1, b1, false, false); \
    v4u w = {r0[0], r1[0], r0[1], r1[1]}; OUT = *reinterpret_cast<bf16x8*>(&w); } while (0)
#define RMFMA(a, b, c) __builtin_amdgcn_mfma_f32_32x32x16_bf16((a), (b), (c), 0, 0, 0)
#define RPRIO(x) __builtin_amdgcn_s_setprio(x)
#define RBAR() do { asm volatile("s_waitcnt lgkmcnt(0)" ::: "memory"); __builtin_amdgcn_s_barrier(); asm volatile("" ::: "memory"); } while (0)

DI void ret_unit(LAS unsigned char* lds, const bf16* __restrict__ QR, const bf16* __restrict__ KR, const bf16* __restrict__ VR, bf16* __restrict__ O,
                 const int rowbase, const int h, const int fwd, const int sl, const float lg) {
    const int tid = opaque_tid(), wid = __builtin_amdgcn_readfirstlane(tid >> 6), lane = tid & 63, r = lane & 31, hi = lane >> 5;
    const int eb = wid >> 2, qb = eb ? 7 - wid : wid, dq = wid & 3;
    const unsigned lbase = (unsigned)(uintptr_t)lds;
    const float lg2 = lg * 1.4426950408889634f;
    const float dC = __builtin_amdgcn_exp2f(lg2 * (float)C);
    const int iq = 32 * qb + r;
    const int kb_lo = fwd ? 0 : qb, ntile = fwd ? qb + 1 : 4 - qb, hup = (ntile + 1) >> 1, t0 = eb ? hup : 0, t1 = eb ? ntile : hup;
    const int vk0 = tid >> 3, vk1 = 64 + (tid >> 3), vch = tid & 7;
    const unsigned vdst0 = lbase + V_OFF + vch * VP + vk0 * 16, vdst1 = lbase + V_OFF + vch * VP + vk1 * 16;
    const bf16* vsrc = VR + (size_t)h * 512 + sl * 64 + vch * 8;
    const bf16* ksrc = KR + ((size_t)((wid >> 2) * 4 + h) * 2 + ((wid >> 1) & 1)) * 8192 + ((wid & 1) * 8 * 64 + lane) * 8;
    const int trblk = (lane >> 4) & 1, trq = (lane & 15) >> 2, trp = lane & 3;
    const unsigned rd_row = lbase + (unsigned)(hi * KP + r * 16);
    const unsigned tr_k = lbase + KT_OFF + (unsigned)((2 * trblk + (trp >> 1)) * KP + (8 * hi + trq) * 16 + 8 * (trp & 1));
    const unsigned tr_v = lbase + V_OFF + (unsigned)((2 * trblk + (trp >> 1)) * VP + (8 * hi + trq) * 16 + 8 * (trp & 1)) + 4 * eb * VP;
    const unsigned p_my = lbase + P_OFF + lane * 16;
    const int pq = fwd ? qb : 3 - qb; const int pslot0 = pq * (pq + 1) / 2;
    f32x16 st0 = {}, st1 = {};
    bf16x8 q[16];
    auto chunk_row = [&](int n) -> int {
        if (fwd) return n < 2 ? rowbase + 128 * n : rowbase + 256 + 128 * (n - 2);
        return n < 2 ? rowbase + 128 * (1 - n) : rowbase + 256 + 128 * (65 - n);
    };
#define ISSUE_K(n) do { const bf16* kp = ksrc + (size_t)(chunk_row(n) >> 6) * 65536; _Pragma("unroll") for (int j = 0; j < 8; ++j) \
        __builtin_amdgcn_global_load_lds((const unsigned*)(kp + j * 512), (LAS unsigned*)(lds + KT_OFF + (wid >> 1) * KTILE + ((wid & 1) * 8 + j) * KP), 16, 0, 0); } while (0)
#define LOAD_V(n, a, b) do { const bf16* vp = vsrc + (size_t)chunk_row(n) * 2048; a = *(const v4u*)(vp + (size_t)vk0 * 2048); b = *(const v4u*)(vp + (size_t)vk1 * 2048); } while (0)
#define WRITE_V(a, b, vbo_) do { v4u t0_, t1_; const float vw0 = __builtin_amdgcn_exp2f(lg2 * (float)(fwd ? (C - 1 - vk0) : vk0)), vw1 = __builtin_amdgcn_exp2f(lg2 * (float)(fwd ? (C - 1 - vk1) : vk1));   \
        t0_.x = cvt_pk_bf16(bf_lo(a.x) * vw0, bf_hi(a.x) * vw0); t0_.y = cvt_pk_bf16(bf_lo(a.y) * vw0, bf_hi(a.y) * vw0); t0_.z = cvt_pk_bf16(bf_lo(a.z) * vw0, bf_hi(a.z) * vw0); t0_.w = cvt_pk_bf16(bf_lo(a.w) * vw0, bf_hi(a.w) * vw0); \
        t1_.x = cvt_pk_bf16(bf_lo(b.x) * vw1, bf_hi(b.x) * vw1); t1_.y = cvt_pk_bf16(bf_lo(b.y) * vw1, bf_hi(b.y) * vw1); t1_.z = cvt_pk_bf16(bf_lo(b.z) * vw1, bf_hi(b.z) * vw1); t1_.w = cvt_pk_bf16(bf_lo(b.w) * vw1, bf_hi(b.w) * vw1); \
        *(LAS v4u*)(uintptr_t)(vdst0 + vbo_) = t0_; *(LAS v4u*)(uintptr_t)(vdst1 + vbo_) = t1_; } while (0)
    { unsigned z_; asm volatile("v_mov_b32 %0, 0" : "=v"(z_));
      for (int i = tid; i < 2 * KTILE / 16; i += 512) *(LAS v4u*)(lds + ST_OFF + i * 16) = (v4u){z_, z_, z_, z_}; }
    v4u va, vb;
    ISSUE_K(0);
    LOAD_V(0, va, vb);
    { const bf16* qp = QR + (size_t)(((chunk_row(2) >> 5) + qb) * 4 + h) * 8192 + lane * 8;
#pragma unroll
      for (int s = 0; s < 16; ++s) q[s] = *(const bf16x8*)(qp + s * 512); }
    WRITE_V(va, vb, 0u);
    LOAD_V(1, va, vb);
#pragma unroll 1
    for (int n = 0; n < 66; ++n) {
        if (n >= 3) asm volatile("s_waitcnt vmcnt(32)" ::: "memory"); else asm volatile("s_waitcnt vmcnt(0)" ::: "memory");
        RBAR();
        const unsigned vb_cur = (unsigned)(n & 1) * VIMG, vb_nxt = (unsigned)((n + 1) & 1) * VIMG;
        const bool lat = n >= 2;
        if (n > 0) {
#pragma unroll
            for (int t = 0; t < 2; ++t) { const int db = 2 * dq + t; const unsigned img = lbase + ST_OFF + (db >> 2) * KTILE + 4 * (db & 3) * KP + (32 * eb + r) * 16 + 8 * hi;
#pragma unroll
                for (int g = 0; g < 4; ++g) { v2u w; const f32x16& sref = t ? st1 : st0; w.x = cvt_pk_bf16(sref[4 * g], sref[4 * g + 1]); w.y = cvt_pk_bf16(sref[4 * g + 2], sref[4 * g + 3]);
                    *(LAS v2u*)(uintptr_t)(img + g * KP) = w; } }
        }
#pragma unroll
        for (int g = 0; g < 16; ++g) { st0[g] *= dC; st1[g] *= dC; }
        {
            const unsigned kb0 = tr_k + (dq >> 1) * KTILE + 8 * (dq & 1) * KP;
            s16x4 v0 = vtr(tr_v + vb_cur), v1 = vtr(tr_v + vb_cur + 64), a0 = vtr(kb0), a1 = vtr(kb0 + 64), b0 = vtr(kb0 + 4 * KP), b1 = vtr(kb0 + 4 * KP + 64);
#pragma unroll
            for (int g = 0; g < 8; ++g) {
                const bf16x8 vf = cat8(v0, v1), kt0 = cat8(a0, a1), kt1 = cat8(b0, b1);
                if (g < 7) { const int g1 = g + 1; const unsigned ka = kb0 + (g1 >> 2) * 2 * KTILE + (32 * ((g1 >> 1) & 1) + 16 * (g1 & 1)) * 16, vaq = tr_v + vb_cur + g1 * 256;
                    v0 = vtr(vaq); v1 = vtr(vaq + 64); a0 = vtr(ka); a1 = vtr(ka + 64); b0 = vtr(ka + 4 * KP); b1 = vtr(ka + 4 * KP + 64); }
                RPRIO(1); st0 = RMFMA(kt0, vf, st0); st1 = RMFMA(kt1, vf, st1); RPRIO(0);
            }
        }
        if (lat) {
#pragma unroll 1
            for (int ti = t0; ti < t1; ++ti) {
                const int kb = kb_lo + ti;
                const unsigned kbase = rd_row + KT_OFF + (kb >> 1) * 2 * KTILE + (kb & 1) * 512;
                f32x16 pt = {};
                bf16x8 c0 = ldsr(kbase), c1 = ldsr(kbase + 2 * KP), c2 = ldsr(kbase + 4 * KP), c3 = ldsr(kbase + 6 * KP);
                __builtin_amdgcn_sched_barrier(0);
#pragma unroll
                for (int sg = 0; sg < 4; ++sg) {
                    bf16x8 n0, n1, n2, n3;
                    if (sg < 3) { const unsigned nb = kbase + ((sg + 1) >> 1) * KTILE + ((sg + 1) & 1) * 8 * KP; n0 = ldsr(nb); n1 = ldsr(nb + 2 * KP); n2 = ldsr(nb + 4 * KP); n3 = ldsr(nb + 6 * KP); }
                    __builtin_amdgcn_sched_barrier(0);
                    RPRIO(1); pt = RMFMA(c0, q[4 * sg], pt); pt = RMFMA(c1, q[4 * sg + 1], pt); pt = RMFMA(c2, q[4 * sg + 2], pt); pt = RMFMA(c3, q[4 * sg + 3], pt); RPRIO(0);
                    __builtin_amdgcn_sched_barrier(0);
                    if (sg < 3) { c0 = n0; c1 = n1; c2 = n2; c3 = n3; }
                }
                const float rowscale = __builtin_amdgcn_exp2f(fwd ? lg2 * (float)(iq - (C - 1)) : -lg2 * (float)iq);
                if (kb == qb) {
#pragma unroll
                    for (int g = 0; g < 16; ++g) { const int j = 32 * kb + crow(g, hi); const bool keep = fwd ? (j <= iq) : (j > iq); pt[g] = keep ? pt[g] * rowscale : 0.f; }
                } else {
#pragma unroll
                    for (int g = 0; g < 16; ++g) pt[g] *= rowscale;
                }
                bf16x8 pa0, pa1; RPK4(pt, 0, pa0); RPK4(pt, 8, pa1);
                const unsigned ps = p_my + (pslot0 + (fwd ? kb : 3 - kb)) * 2048;
                *(LAS bf16x8*)(uintptr_t)ps = pa0; *(LAS bf16x8*)(uintptr_t)(ps + 1024) = pa1;
            }
        }
        RBAR();
        if (n + 1 < 66) WRITE_V(va, vb, vb_nxt);
        if (n + 2 < 66) LOAD_V(n + 2, va, vb);
        if (n + 1 < 66) ISSUE_K(n + 1);
        if (lat) {
            f32x16 opv = {};
            {
                unsigned ps = p_my + (pslot0 + (fwd ? kb_lo : 3 - kb_lo)) * 2048, vaq = tr_v + vb_cur + kb_lo * 512;
                bf16x8 pa0 = ldsr(ps), pa1 = ldsr(ps + 1024); s16x4 x0 = vtr(vaq), x1 = vtr(vaq + 64), x2 = vtr(vaq + 256), x3 = vtr(vaq + 320);
#pragma unroll 1
                for (int ti = 0; ti < ntile; ++ti) {
                    const bf16x8 ca0 = pa0, ca1 = pa1, vf0 = cat8(x0, x1), vf1 = cat8(x2, x3);
                    if (ti + 1 < ntile) { ps += fwd ? 2048 : -2048; vaq += 512; pa0 = ldsr(ps); pa1 = ldsr(ps + 1024); x0 = vtr(vaq); x1 = vtr(vaq + 64); x2 = vtr(vaq + 256); x3 = vtr(vaq + 320); }
                    RPRIO(1); opv = RMFMA(ca0, vf0, opv); opv = RMFMA(ca1, vf1, opv); RPRIO(0);
                }
            }
            f32x16 oqs = {};
            const bool more = n + 1 < 66;
            const bf16* qp = QR + (size_t)(((chunk_row(more ? n + 1 : n) >> 5) + qb) * 4 + h) * 8192 + lane * 8;
            const unsigned sbase = rd_row + ST_OFF + eb * 512;
            bf16x8 c0 = ldsr(sbase), c1 = ldsr(sbase + 2 * KP), c2 = ldsr(sbase + 4 * KP), c3 = ldsr(sbase + 6 * KP);
            __builtin_amdgcn_sched_barrier(0);
#pragma unroll
            for (int sg = 0; sg < 4; ++sg) {
                bf16x8 n0, n1, n2, n3;
                if (sg < 3) { const unsigned nb = sbase + ((sg + 1) >> 1) * KTILE + ((sg + 1) & 1) * 8 * KP; n0 = ldsr(nb); n1 = ldsr(nb + 2 * KP); n2 = ldsr(nb + 4 * KP); n3 = ldsr(nb + 6 * KP); }
                __builtin_amdgcn_sched_barrier(0);
                RPRIO(1); oqs = RMFMA(q[4 * sg], c0, oqs); oqs = RMFMA(q[4 * sg + 1], c1, oqs); oqs = RMFMA(q[4 * sg + 2], c2, oqs); oqs = RMFMA(q[4 * sg + 3], c3, oqs); RPRIO(0);
                __builtin_amdgcn_sched_barrier(0);
                if (sg < 3) { c0 = n0; c1 = n1; c2 = n2; c3 = n3; }
            }
#pragma unroll
            for (int s = 0; s < 16; ++s) q[s] = *(const bf16x8*)(qp + s * 512);
            asm volatile("" ::: "memory");
            bf16* op = O + (size_t)(chunk_row(n) + 32 * qb) * 2048 + h * 512 + sl * 64 + eb * 32 + r;
#pragma unroll
            for (int g = 0; g < 16; ++g) { const int i = 32 * qb + crow(g, hi);
                const float a = __builtin_amdgcn_exp2f(lg2 * (float)(fwd ? (i + 1) : (C - i)));
                op[(size_t)crow(g, hi) * 2048] = (bf16)(cvt_pk_bf16(opv[g] + a * oqs[g], 0.f) & 0xffffu); }
        }
    }
    asm volatile("s_waitcnt vmcnt(0)" ::: "memory");
    __syncthreads();
#undef ISSUE_K
#undef RPRIO
#undef LOAD_V
#undef WRITE_V
}
#undef RPK4
#undef RMFMA
#undef RBAR
}

struct Args { const float* in[22]; float* out; unsigned char* ws; };
typedef const __attribute__((address_space(4))) Args CArgs;
DI CArgs* kargs() { CArgs* p = (CArgs*)__builtin_amdgcn_kernarg_segment_ptr(); asm volatile("" : "+s"(p)); return p; }
struct Frame {
    LAS unsigned char* lds;
    volatile LAS unsigned* MISC;
};
DI int frame_vcu() { const int G = (int)gridDim.x, bx = (int)blockIdx.x; return (G % 8 == 0) ? (bx % 8) * (G / 8) + bx / 8 : bx; }
enum InIdx { I_X = 0, I_C, I_CTX, I_CCTX, I_NORM1, I_NORM2, I_WADA, I_BADA, I_WIN, I_DECF, I_DECB, I_QN, I_KN, I_WRO, I_WAO, I_WOUT, I_WR, I_BR, I_W1, I_B1, I_W2, I_B2 };

template <bool FP8> DI void transpose_task(const float* W, int K, int N, void* WTv, int k0, int n0, int drow0, int lane) {
    const int kr = lane >> 4, c4 = lane & 15;
    const float* src = W + (size_t)(k0 + 8 * kr) * N + n0 + 4 * c4;
    bf16* dst = (bf16*)WTv + (size_t)(drow0 + 4 * c4) * K + k0 + 8 * kr; unsigned char* dst8 = (unsigned char*)WTv + (size_t)(drow0 + 4 * c4) * K + k0 + 8 * kr;
#pragma unroll 2
    for (int g = 0; g < 8; ++g) {
        f32x4 v[8];
#pragma unroll
        for (int j = 0; j < 8; ++j) v[j] = __builtin_nontemporal_load((const GAS f32x4*)(src + (size_t)(32 * g + j) * N));
#pragma unroll
        for (int cc = 0; cc < 4; ++cc) {
            if constexpr (FP8) { v2u o; o.x = pk4_fp8(16.f * v[0][cc], 16.f * v[1][cc], 16.f * v[2][cc], 16.f * v[3][cc]); o.y = pk4_fp8(16.f * v[4][cc], 16.f * v[5][cc], 16.f * v[6][cc], 16.f * v[7][cc]);     *(GAS v2u*)(dst8 + (size_t)cc * K + 32 * g) = o; }
            else { v4u o; o.x = cvt_pk_bf16(v[0][cc], v[1][cc]); o.y = cvt_pk_bf16(v[2][cc], v[3][cc]); o.z = cvt_pk_bf16(v[4][cc], v[5][cc]); o.w = cvt_pk_bf16(v[6][cc], v[7][cc]);
                *(GAS v4u*)(dst + (size_t)cc * K + 32 * g) = o; } }
    }
}
DI int win_dest_row(int n0) {
    if (n0 >= 2048) return n0;
    const int hb = n0 & ~255, c = n0 & 255, blk = c >> 6, within = c & 63;
    const int nb = blk == 1 ? 2 : (blk == 2 ? 1 : blk);
    return hb + nb * 64 + within;
}
DI int w1_dest_row(int n0) { const int up = n0 >= 1024, c = n0 & 1023; return 256 * (c >> 7) + 128 * up + (c & 127); }

DI void p0_prologue(Frame& F, CArgs* ap) {
    const int L_tid = opaque_tid(), L_lane = L_tid & 63, L_wave = __builtin_amdgcn_readfirstlane(L_tid >> 6);
    unsigned char* ws = ap->ws;
    const int gw = frame_vcu() * NWAVES + L_wave, NGW = ((int)gridDim.x) * NWAVES;
    const int ab_ = frame_vcu() - (((int)gridDim.x) - 96);
    if (ab_ >= 0) {
        LAS float* sc = (LAS float*)(F.lds);
        LAS float* red = (LAS float*)(F.lds + 40960);
        const float* cin = ap->in[I_C]; const float* cctx = ap->in[I_CCTX];
        for (int i = L_tid; i < 9 * 1024; i += 512) { const float v = i < 8192 ? cin[i] : cctx[i - 8192]; sc[i] = v * fast_sigmoid(v); }
        __syncthreads();
        const int n = ab_ * 64 + L_lane; const float* wa = ap->in[I_WADA];
        float acc[9];
#pragma unroll
        for (int r = 0; r < 9; ++r) acc[r] = 0.f;
        for (int k = L_wave * 128; k < L_wave * 128 + 128; ++k) { const float w = wa[(size_t)k * 6144 + n];
#pragma unroll
            for (int r = 0; r < 9; ++r) acc[r] += sc[r * 1024 + k] * w; }
#pragma unroll
        for (int r = 0; r < 9; ++r) red[(L_wave * 9 + r) * 64 + L_lane] = acc[r];
        __syncthreads();
        float* mod = (float*)(ws + WS_MOD);
        for (int i = L_tid; i < 9 * 64; i += 512) { const int r = i >> 6, l = i & 63; float s = ap->in[I_BADA][ab_ * 64 + l];
#pragma unroll
            for (int w = 0; w < 8; ++w) s += red[(w * 9 + r) * 64 + l];
            mod[(size_t)r * 6144 + ab_ * 64 + l] = s; }
        __syncthreads();
    }
    if (frame_vcu() == (((int)gridDim.x) >= 97 ? ((int)gridDim.x) - 97 : 0)) {
        float* cosr = (float*)(ws + WS_COSR); float* sinr = (float*)(ws + WS_SINR); float* cosa = (float*)(ws + WS_COSA); float* sina = (float*)(ws + WS_SINA);
        for (int i = L_tid; i < 128 * 64; i += 512) { const int pos = i >> 6, f = i & 63; const float inv = powf(10000.0f, -(float)f / 64.0f); const float ang = (float)pos * inv; cosr[i] = cosf(ang); sinr[i] = sinf(ang); }
        for (int i = L_tid; i < 128 * 32; i += 512) { const int pos = i >> 5, f = i & 31; const float inv = powf(10000.0f, -(float)f / 32.0f); const float ang = (float)pos * inv; cosa[i] = cosf(ang); sina[i] = sinf(ang); }
    }
    constexpr int T_IN = (INW / 64) * 4, T_RO = 16 * 8, T_AO = 16 * 4, T_OUT = 16 * 4, T_E1 = 32 * 4, T_E2 = 16 * 4;
    constexpr int NTASK = T_IN + T_RO + T_AO + T_OUT + NEXP * T_E1 + NEXP * T_E2;
    for (int it = gw; it < NTASK; it += NGW) {
        int r = it;
        if (r < T_IN) { const int nb = r >> 2, kq = r & 3; transpose_task<true>(ap->in[I_WIN], 1024, INW, (unsigned char*)(ws + WS_WIN), 256 * kq, 64 * nb, win_dest_row(64 * nb), L_lane); continue; } r -= T_IN;
        if (r < T_RO) { const int nb = r >> 3, kq = r & 7; transpose_task<true>(ap->in[I_WRO], 2048, 1024, (unsigned char*)(ws + WS_WRO), 256 * kq, 64 * nb, 64 * nb, L_lane); continue; } r -= T_RO;
        if (r < T_AO) { const int nb = r >> 2, kq = r & 3; transpose_task<true>(ap->in[I_WAO], 1024, 1024, (unsigned char*)(ws + WS_WAO), 256 * kq, 64 * nb, 64 * nb, L_lane); continue; } r -= T_AO;
        if (r < T_OUT) { const int nb = r >> 2, kq = r & 3; transpose_task<true>(ap->in[I_WOUT], 1024, 1024, (unsigned char*)(ws + WS_WOUT), 256 * kq, 64 * nb, 64 * nb, L_lane); continue; } r -= T_OUT;
        if (r < NEXP * T_E1) { const int e = r / T_E1, q = r % T_E1, nb = q >> 2, kq = q & 3;
            transpose_task<true>(ap->in[I_W1] + (size_t)e * 1024 * 2048, 1024, 2048, (unsigned char*)(ws + WS_W1) + (size_t)e * 2048 * 1024, 256 * kq, 64 * nb, w1_dest_row(64 * nb), L_lane); continue; } r -= NEXP * T_E1;
        { const int e = r / T_E2, q = r % T_E2, nb = q >> 2, kq = q & 3;
            transpose_task<true>(ap->in[I_W2] + (size_t)e * 1024 * 1024, 1024, 1024, (unsigned char*)(ws + WS_W2) + (size_t)e * 1024 * 1024, 256 * kq, 64 * nb, 64 * nb, L_lane); }
    }
}

DI void p_modulate(Frame& F, CArgs* ap) {
    const int L_tid = opaque_tid(), L_lane = L_tid & 63, L_wave = __builtin_amdgcn_readfirstlane(L_tid >> 6);
    const unsigned char* ws = ap->ws; const float* mod = (const float*)(ws + WS_MOD); unsigned char* H1 = ap->ws + WS_H1;
    const int gw = frame_vcu() * NWAVES + L_wave, NGW = ((int)gridDim.x) * NWAVES;
    const int per = (MROWS + NGW - 1) / NGW; const int r0 = gw * per, r1 = (r0 + per) < MROWS ? (r0 + per) : MROWS;
    int cur = -1; f32x4 pa[4], pb[4];
    for (int rowb = r0; rowb < r1; rowb += 3) {
        f32x4 v[3][4];
#pragma unroll
        for (int q = 0; q < 3; ++q) { const int row = (rowb + q) < r1 ? (rowb + q) : (r1 - 1); const int b = row / LT, p = row - b * LT;
            const float* src = p < LCTX ? ap->in[I_CTX] + ((size_t)b * LCTX + p) * DM : ap->in[I_X] + ((size_t)b * SEQ + (p - LCTX)) * DM;
#pragma unroll
            for (int j = 0; j < 4; ++j) v[q][j] = __builtin_nontemporal_load((const GAS f32x4*)src + 64 * j + L_lane); }
#pragma unroll
        for (int q = 0; q < 3; ++q) { const int row = rowb + q; if (row < r1) {
            const int b = row / LT, p = row - b * LT; const int id = p < LCTX ? 8 : b;
            if (id != cur) { cur = id;
#pragma unroll
                for (int j = 0; j < 4; ++j) { const int k = 256 * j + 4 * L_lane; const f32x4 g = *(const f32x4*)(ap->in[I_NORM1] + k), sh = *(const f32x4*)(mod + (size_t)id * 6144 + k), sc = *(const f32x4*)(mod + (size_t)id * 6144 + 1024 + k);
                    pa[j] = g * (sc + 1.0f); pb[j] = sh; } }
            float s = 0.f;
#pragma unroll
            for (int j = 0; j < 4; ++j) s += (v[q][j].x * v[q][j].x + v[q][j].y * v[q][j].y) + (v[q][j].z * v[q][j].z + v[q][j].w * v[q][j].w);
            const float rstd = 1.0f / sqrtf(wave_sum(s) * (1.0f / DM) + EPS);
            GAS unsigned* o = (GAS unsigned*)(H1 + (size_t)row * DM) + L_lane;
#pragma unroll
            for (int j = 0; j < 4; ++j) { const f32x4 y = (v[q][j] * rstd * pa[j] + pb[j]) * 4.0f;
                o[64 * j] = pk4_fp8(__builtin_amdgcn_fmed3f(y.x, -448.f, 448.f), __builtin_amdgcn_fmed3f(y.y, -448.f, 448.f), __builtin_amdgcn_fmed3f(y.z, -448.f, 448.f), __builtin_amdgcn_fmed3f(y.w, -448.f, 448.f)); } } }
    }
}

DI void p_ar(Frame& F, CArgs* ap) {
    const int L_tid = opaque_tid(), L_lane = L_tid & 63, L_wave = __builtin_amdgcn_readfirstlane(L_tid >> 6);
    unsigned char* ws = ap->ws; const int gw = frame_vcu() * NWAVES + L_wave, NGW = ((int)gridDim.x) * NWAVES;
    bf16* GR = (bf16*)(ws + WS_GR); const bf16* OF = (const bf16*)(ws + WS_OF); const bf16* OB = (const bf16*)(ws + WS_OB);
    for (int i = gw; i < NBH * SEQ; i += NGW) {
        const int row = (i >> 13) * LT + LCTX + (i & 8191);
        v4u qa[4], qb[4], qg[4];
#pragma unroll
        for (int hh = 0; hh < 4; ++hh) { const size_t off = (size_t)row * 2048 + hh * 512 + 8 * L_lane; qa[hh] = *(const v4u*)(OF + off); qb[hh] = *(const v4u*)(OB + off); qg[hh] = *(const v4u*)(GR + off); }
#pragma unroll
        for (int hh = 0; hh < 4; ++hh) {
            f32x4 a0, a1, b0, b1, g0, g1; pg8::unpack8(qa[hh], a0, a1); pg8::unpack8(qb[hh], b0, b1); pg8::unpack8(qg[hh], g0, g1);
            a0 += b0; a1 += b1;
            float s = (a0.x * a0.x + a0.y * a0.y) + (a0.z * a0.z + a0.w * a0.w) + (a1.x * a1.x + a1.y * a1.y) + (a1.z * a1.z + a1.w * a1.w);
            const float rstd = 4.0f / sqrtf(wave_sum(s) * (1.0f / 512.0f) + EPS);
            const f32x4 y0 = a0 * g0 * rstd, y1 = a1 * g1 * rstd; v2u w;
#define AQ(v) __builtin_amdgcn_fmed3f((v), -448.f, 448.f)
            w.x = pk4_fp8(AQ(y0.x), AQ(y0.y), AQ(y0.z), AQ(y0.w)); w.y = pk4_fp8(AQ(y1.x), AQ(y1.y), AQ(y1.z), AQ(y1.w));
#undef AQ
            *(v2u*)((unsigned char*)GR + (size_t)row * 4096 + hh * 512 + 8 * L_lane) = w;
        }
    }
}
DI void p_knorm(Frame& F, CArgs* ap) {
    const int L_tid = opaque_tid(), L_lane = L_tid & 63, L_wave = __builtin_amdgcn_readfirstlane(L_tid >> 6);
    unsigned char* ws = ap->ws; const int gw = frame_vcu() * NWAVES + L_wave, NGW = ((int)gridDim.x) * NWAVES;
    const bf16* KA = (const bf16*)(ws + WS_KA); unsigned char* KA8 = ws + WS_KA8; const float* kn = ap->in[I_KN]; const float* cosa = (const float*)(ws + WS_COSA); const float* sina = (const float*)(ws + WS_SINA);
    const int d = (4 * L_lane) & 127;
    const f32x4 gk = *(const f32x4*)(kn + d);
    for (int row = gw; row < MH; row += NGW) {
        const int p = row % LT; const GAS v2u* ptr = (const GAS v2u*)(KA + (size_t)row * 256) + L_lane;
        const v2u w = *ptr; f32x4 v = {bf_lo(w.x), bf_hi(w.x), bf_lo(w.y), bf_hi(w.y)};
        float s = (v.x * v.x + v.y * v.y) + (v.z * v.z + v.w * v.w);
        s += lane_xor<1>(s); s += lane_xor<2>(s); s += lane_xor<4>(s); s += lane_xor<8>(s); s += lane_xor<16>(s);
        v = v * (1.0f / sqrtf(s * (1.0f / 128.0f) + EPS)) * gk;
        if (p >= LCTX) {
            const int t = p - LCTX, axis = (d >> 6) & 1, half = (d >> 5) & 1, f = d & 31, pos = axis ? (t & 63) : (t >> 6);
            const f32x4 cs = *(const f32x4*)(cosa + pos * 32 + f), sn = *(const f32x4*)(sina + pos * 32 + f);
            f32x4 o; o.x = lane_xor<8>(v.x); o.y = lane_xor<8>(v.y); o.z = lane_xor<8>(v.z); o.w = lane_xor<8>(v.w);
            v = half ? (v * cs + o * sn) : (v * cs - o * sn);
        }
        *(unsigned*)(KA8 + ((size_t)(L_lane >> 5) * MH + row) * 128 + (((((L_lane & 31) >> 2) ^ ((row >> 1) & 7)) << 4) | (4 * (L_lane & 3)))) =
            pk4_fp8(__builtin_amdgcn_fmed3f(v.x, -448.f, 448.f), __builtin_amdgcn_fmed3f(v.y, -448.f, 448.f), __builtin_amdgcn_fmed3f(v.z, -448.f, 448.f), __builtin_amdgcn_fmed3f(v.w, -448.f, 448.f));
    }
}

DI void p_vprep(Frame& F, CArgs* ap) {
    const int L_tid = opaque_tid(), L_lane = L_tid & 63, L_wave = __builtin_amdgcn_readfirstlane(L_tid >> 6);
    unsigned char* ws = ap->ws; const int gw = frame_vcu() * NWAVES + L_wave, NGW = ((int)gridDim.x) * NWAVES;
    for (int it = gw; it < (MH / 64) * 2; it += NGW) {
        const int tile = it >> 1, kvh = it & 1;
        const bf16* src = (const bf16*)(ws + WS_VA) + (size_t)tile * 64 * 256 + kvh * 128 + 2 * L_lane;
        unsigned char* dst = ws + WS_VA8 + ((size_t)kvh * (MH / 64) + tile) * 8192 + 128 * L_lane;
        const int x = (L_lane >> 1) & 3;
#pragma unroll
        for (int c = 0; c < 4; ++c) {
            v4u lo, hi_;
#pragma unroll
            for (int e = 0; e < 4; ++e) { const int q = 4 * c + e, k0 = 32 * ((q >> 2) & 1) + 8 * (q & 3) + 4 * (q >> 3);
                const unsigned w0 = *(const unsigned*)(src + (k0 + 0) * 256), w1 = *(const unsigned*)(src + (k0 + 1) * 256), w2 = *(const unsigned*)(src + (k0 + 2) * 256), w3 = *(const unsigned*)(src + (k0 + 3) * 256);
#define VQ(v) __builtin_amdgcn_fmed3f((v) * 8.0f, -448.f, 448.f)
                lo[e] = pk4_fp8(VQ(bf_lo(w0)), VQ(bf_lo(w1)), VQ(bf_lo(w2)), VQ(bf_lo(w3))); hi_[e] = pk4_fp8(VQ(bf_hi(w0)), VQ(bf_hi(w1)), VQ(bf_hi(w2)), VQ(bf_hi(w3)));
#undef VQ
            }
            *(v4u*)(dst + ((c ^ x) << 4)) = lo; *(v4u*)(dst + 64 + ((c ^ x) << 4)) = hi_;
        }
    }
}
template <int S> DI int ar_partner(int v) {
    if constexpr (S == 0) return __builtin_amdgcn_update_dpp(v, v, 0xB1, 0xf, 0xf, false);
    else if constexpr (S == 1) return __builtin_amdgcn_update_dpp(v, v, 0x4E, 0xf, 0xf, false);
    else if constexpr (S == 2) return __builtin_amdgcn_update_dpp(v, v, 0x141, 0xf, 0xf, false);
    else if constexpr (S == 3) return __builtin_amdgcn_update_dpp(v, v, 0x140, 0xf, 0xf, false);
    else return __builtin_amdgcn_ds_swizzle(v, 0x1f | (16 << 10));
}
#define TOP_STEP(S) { const float ov = __int_as_float(ar_partner<S>(__float_as_int(bv))); const int oe = ar_partner<S>(be); if (ov > bv || (ov == bv && oe < be)) { bv = ov; be = oe; } }
DI void p_router(Frame& F, CArgs* ap) {
    const int L_tid = opaque_tid(), L_lane = L_tid & 63, L_wave = __builtin_amdgcn_readfirstlane(L_tid >> 6);
    unsigned char* ws = ap->ws; const int gw = frame_vcu() * NWAVES + L_wave, NGW = ((int)gridDim.x) * NWAVES;
    LAS float* wrs = (LAS float*)F.lds;
    LAS float* xs = (LAS float*)(F.lds + 16384) + L_wave * (32 * 129);
    const float* mod = (const float*)(ws + WS_MOD); const float* x1 = ap->out; unsigned char* H2 = (unsigned char*)(ws + WS_H2);
    int* tope = (int*)(ws + WS_TOPE); float* topw = (float*)(ws + WS_TOPW); int* wcnt = (int*)(ws + WS_WCNT);
    const int e_l = L_lane & 31, hi = L_lane >> 5; const float bias = ap->in[I_BR][e_l];
    const int nit = (TTOK / 32 + NGW - 1) / NGW;
    for (int it = 0; it < nit; ++it) {
        const int ch = gw + it * NGW; const bool active = ch < TTOK / 32; const int chc = active ? ch : 0;
        const int b = (chc * 32) / SEQ; float rs = 0.f;
        {
            f32x4 pa[4], pb[4];
#pragma unroll
            for (int j = 0; j < 4; ++j) { const int k = 512 * (j >> 1) + 8 * L_lane + 4 * (j & 1); const f32x4 g = *(const f32x4*)(ap->in[I_NORM2] + k), sh = *(const f32x4*)(mod + (size_t)b * 6144 + 3072 + k), sc = *(const f32x4*)(mod + (size_t)b * 6144 + 4096 + k);
                pa[j] = g * (sc + 1.0f); pb[j] = sh; }
            if (active) for (int tb = 0; tb < 32; tb += 4) {
                v4u raw[4][2];
#pragma unroll
                for (int q = 0; q < 4; ++q) { const bf16* src = (const bf16*)(x1 + (size_t)(ch * 32 + tb + q) * DM);
#pragma unroll
                    for (int j = 0; j < 2; ++j) raw[q][j] = *((const GAS v4u*)src + 64 * j + L_lane); }
#pragma unroll
                for (int q = 0; q < 4; ++q) { const int tt = tb + q, t = ch * 32 + tt; float s = 0.f; f32x4 v[4];
                    pg8::unpack8(raw[q][0], v[0], v[1]); pg8::unpack8(raw[q][1], v[2], v[3]);
#pragma unroll
                    for (int j = 0; j < 4; ++j) s += (v[j].x * v[j].x + v[j].y * v[j].y) + (v[j].z * v[j].z + v[j].w * v[j].w);
                    const float rstd = 1.0f / sqrtf(wave_sum(s) * (1.0f / DM) + EPS);
                    rs = (e_l == tt) ? rstd : rs;
                    GAS v2u* o = (GAS v2u*)(H2 + (size_t)t * DM) + L_lane;
#pragma unroll
                    for (int j = 0; j < 2; ++j) { const f32x4 y0 = v[2 * j] * rstd * pa[2 * j] + pb[2 * j], y1 = v[2 * j + 1] * rstd * pa[2 * j + 1] + pb[2 * j + 1];
                        v2u w; w.x = pk4_fp8(4.f * y0.x, 4.f * y0.y, 4.f * y0.z, 4.f * y0.w); w.y = pk4_fp8(4.f * y1.x, 4.f * y1.y, 4.f * y1.z, 4.f * y1.w); o[64 * j] = w; } }
            }
        }
        f32x16 acc = {};
        v2u xr[16]; f32x4 wq0, wq1, pg, psh, psc;
        { const int k4 = 4 * e_l;
#pragma unroll
            for (int i2 = 0; i2 < 16; ++i2) xr[i2] = *(const GAS v2u*)((const bf16*)(x1 + (size_t)(chc * 32 + 2 * i2 + hi) * DM) + k4);
            const f32x4* wsrc = (const f32x4*)(ap->in[I_WR]); wq0 = wsrc[L_tid]; wq1 = wsrc[L_tid + 512];
            pg = *(const f32x4*)(ap->in[I_NORM2] + k4); psh = *(const f32x4*)(mod + (size_t)b * 6144 + 3072 + k4); psc = *(const f32x4*)(mod + (size_t)b * 6144 + 4096 + k4); }
        for (int sl = 0; sl < 8; ++sl) {
            __syncthreads();
            *(LAS f32x4*)(wrs + 4 * L_tid) = wq0; *(LAS f32x4*)(wrs + 4 * (L_tid + 512)) = wq1;
            { const f32x4 pa = pg * (psc + 1.0f), sh = psh;
#pragma unroll
                for (int i2 = 0; i2 < 16; ++i2) { const int tok = 2 * i2 + hi; const float r = __shfl(rs, tok);
                    const f32x4 x = {bf_lo(xr[i2].x), bf_hi(xr[i2].x), bf_lo(xr[i2].y), bf_hi(xr[i2].y)}; const f32x4 y = x * r * pa + sh;
                    LAS float* d = xs + tok * 129 + 4 * e_l; d[0] = y.x; d[1] = y.y; d[2] = y.z; d[3] = y.w; } }
            { const int sn = sl < 7 ? sl + 1 : 7; const int kn = sn * 128 + 4 * e_l;
#pragma unroll
                for (int i2 = 0; i2 < 16; ++i2) xr[i2] = *(const GAS v2u*)((const bf16*)(x1 + (size_t)(chc * 32 + 2 * i2 + hi) * DM) + kn);
                const f32x4* wsrc = (const f32x4*)(ap->in[I_WR] + (size_t)sn * 128 * 32); wq0 = wsrc[L_tid]; wq1 = wsrc[L_tid + 512];
                pg = *(const f32x4*)(ap->in[I_NORM2] + kn); psh = *(const f32x4*)(mod + (size_t)b * 6144 + 3072 + kn); psc = *(const f32x4*)(mod + (size_t)b * 6144 + 4096 + kn); }
            __syncthreads();
#pragma unroll 8
            for (int s = 0; s < 64; ++s) acc = __builtin_amdgcn_mfma_f32_32x32x2f32(xs[e_l * 129 + 2 * s + hi], wrs[(2 * s + hi) * 32 + e_l], acc, 0, 0, 0);
        }
        int cnt = 0;
#pragma unroll
        for (int g = 0; g < 16; ++g) {
            const int tok = (g & 3) + 8 * (g >> 2) + 4 * hi; float lv = acc[g] + bias; int se[4]; float sv[4];
#pragma unroll
            for (int k = 0; k < 4; ++k) { float bv = lv; int be = e_l;
                TOP_STEP(0) TOP_STEP(1) TOP_STEP(2) TOP_STEP(3) TOP_STEP(4)
                se[k] = be; sv[k] = bv; if (e_l == be) { lv = -3.0e38f; ++cnt; } }
            const float e1 = __expf(sv[1] - sv[0]), e2 = __expf(sv[2] - sv[0]), e3 = __expf(sv[3] - sv[0]); const float inv = 1.0f / (1.0f + e1 + e2 + e3);
            if (active && e_l == 0) { const int t = ch * 32 + tok; *(int4*)(tope + (size_t)t * 4) = make_int4(se[0], se[1], se[2], se[3]); *(float4*)(topw + (size_t)t * 4) = make_float4(inv, e1 * inv, e2 * inv, e3 * inv); }
        }
        cnt += __shfl_xor(cnt, 32);
        if (active && L_lane < 32) wcnt[ch * 32 + L_lane] = cnt;
    }
}

DI void p_sort(Frame& F, CArgs* ap) {
    const int L_tid = opaque_tid(), L_lane = L_tid & 63, L_wave = __builtin_amdgcn_readfirstlane(L_tid >> 6);
    const int G_ = (int)gridDim.x, GH_ = G_ >> 1; const int th = frame_vcu() >= GH_ ? 1 : 0, lv_ = frame_vcu() - th * GH_;
    unsigned char* ws = ap->ws; const int gw = lv_ * NWAVES + L_wave, NGW = GH_ * NWAVES;
    LAS int* cnt = (LAS int*)F.lds;
    LAS int* segsum = (LAS int*)(F.lds + MISC_OFF + 256);
    LAS int* tot = segsum + 512;
    LAS int* tileb = tot + 32;
    const int* wc = (const int*)(ws + WS_WCNT) + (size_t)th * 1024 * 32;
    for (int i = L_tid; i < 1024 * 32 / 4; i += 512) *(LAS v4u*)(cnt + 4 * i) = *(const v4u*)(wc + 4 * i);
    __syncthreads();
    { const int e = L_tid & 31, seg = L_tid >> 5; int s = 0; for (int w = 0; w < 64; ++w) s += cnt[(seg * 64 + w) * 32 + e]; segsum[seg * 32 + e] = s; }
    __syncthreads();
    if (L_tid < 32) { int s = 0; for (int g = 0; g < 16; ++g) s += segsum[g * 32 + L_tid]; tot[L_tid] = s; }
    __syncthreads();
    if (L_tid == 0) { int a = 0; for (int e = 0; e < 32; ++e) { tileb[e] = a; a += (tot[e] + 255) >> 8; } tileb[32] = a; }
    __syncthreads();
    int* rowtok = (int*)(ws + WS_ROWTOK + (size_t)th * TH_TAB); int* rowdst = (int*)(ws + WS_ROWDST) + (size_t)th * TH_TOK * 4; float* roww = (float*)(ws + WS_ROWW + (size_t)th * TH_TAB);
    if (lv_ == GH_ - 1) { int* tb = (int*)(ws + WS_TILEB + (size_t)th * TH_TAB); if (L_tid < 33) tb[L_tid] = tileb[L_tid];
        for (int t = L_tid; t < tileb[32]; t += 512) { int e = 0; for (int q = 1; q < 32; ++q) if (t >= tileb[q]) e = q; tb[64 + t] = e; } }
    for (int e = lv_; e < 32; e += GH_) { const int r0 = tileb[e] * 256 + tot[e], r1 = tileb[e + 1] * 256;
        for (int r = r0 + L_tid; r < r1; r += 512) { rowtok[r] = th * TH_TOK; roww[r] = 0.f; } }
    const int* tope = (const int*)(ws + WS_TOPE); const float* topw = (const float*)(ws + WS_TOPW);
    for (int wcl = gw; wcl < 1024; wcl += NGW) {
        int run = 0;
        { const int e = L_lane & 31, h = L_lane >> 5, seg = wcl >> 6; int a = 0;
#pragma unroll 4
            for (int g = h; g < seg; g += 2) a += segsum[g * 32 + e];
#pragma unroll 4
            for (int w = seg * 64 + h; w < wcl; w += 2) a += cnt[w * 32 + e];
            const auto sw_ = __builtin_amdgcn_permlane32_swap((unsigned)a, (unsigned)a, false, false);
            run = tileb[e] * 256 + (int)(sw_[0] + sw_[1]); }
        { const int tl = wcl * 32 + (L_lane & 31), t = th * TH_TOK + tl; const bool lo = L_lane < 32;
            const int4 es = *(const int4*)(tope + (size_t)t * 4); const float4 wsv = *(const float4*)(topw + (size_t)t * 4);
            int p0 = 0, p1 = 0, p2 = 0, p3 = 0;
#pragma unroll
            for (int e = 0; e < 32; ++e) { const int base = __builtin_amdgcn_readlane(run, e);
                const bool has = lo && (es.x == e || es.y == e || es.z == e || es.w == e);
                const unsigned m = (unsigned)__ballot(has);
                const int pos = base + (int)__builtin_amdgcn_mbcnt_lo(m, 0u);
                p0 = es.x == e ? pos : p0; p1 = es.y == e ? pos : p1; p2 = es.z == e ? pos : p2; p3 = es.w == e ? pos : p3; }
            if (lo) { rowtok[p0] = t; rowtok[p1] = t; rowtok[p2] = t; rowtok[p3] = t; roww[p0] = wsv.x; roww[p1] = wsv.y; roww[p2] = wsv.z; roww[p3] = wsv.w;
                *(int4*)(rowdst + (size_t)tl * 4) = make_int4(p0, p1, p2, p3); } }
    }
}

DI void p_combine(Frame& F, CArgs* ap, const int th) {
    const int L_tid = opaque_tid(), L_lane = L_tid & 63, L_wave = __builtin_amdgcn_readfirstlane(L_tid >> 6);
    unsigned char* ws = ap->ws; const int gw = frame_vcu() * NWAVES + L_wave, NGW = ((int)gridDim.x) * NWAVES;
    const float* mod = (const float*)(ws + WS_MOD); const bf16* Y2 = (const bf16*)(ws + WS_Y2); const int* tokpos = (const int*)(ws + WS_ROWDST) + (size_t)th * TH_TOK * 4;
    for (int tl = gw; tl < TH_TOK; tl += NGW) {
        const int t = th * TH_TOK + tl, b = t / SEQ; const int4 pp = *(const int4*)(tokpos + (size_t)tl * 4); const int prow[4] = {pp.x, pp.y, pp.z, pp.w};
        float* op = ap->out + (size_t)t * DM; const bf16* xb = (const bf16*)op;
        v4u xr[2]; f32x4 a[2][2], gq[2][2];
#pragma unroll
        for (int jj = 0; jj < 2; ++jj) { const int c0 = 512 * jj + 8 * L_lane;
            xr[jj] = *(const v4u*)(xb + c0); a[jj][0] = (f32x4){0.f, 0.f, 0.f, 0.f}; a[jj][1] = (f32x4){0.f, 0.f, 0.f, 0.f};
#pragma unroll
            for (int s = 0; s < 4; ++s) { f32x4 y0, y1; pg8::unpack8(__builtin_nontemporal_load((const v4u*)(Y2 + (size_t)prow[s] * 1024 + c0)), y0, y1); a[jj][0] += y0; a[jj][1] += y1; }
            gq[jj][0] = *(const f32x4*)(mod + (size_t)b * 6144 + 5120 + c0); gq[jj][1] = *(const f32x4*)(mod + (size_t)b * 6144 + 5120 + c0 + 4); }
        asm volatile("s_waitcnt vmcnt(0)" ::: "memory");
#pragma unroll
        for (int jj = 0; jj < 2; ++jj) { const int c0 = 512 * jj + 8 * L_lane; f32x4 x0, x1v; pg8::unpack8(xr[jj], x0, x1v);
            __builtin_nontemporal_store(x0 + gq[jj][0] * a[jj][0], (f32x4*)(op + c0)); __builtin_nontemporal_store(x1v + gq[jj][1] * a[jj][1], (f32x4*)(op + c0 + 4)); }
    }
}

#ifdef DIAG_ATT
#ifndef DIAG_BL
#define DIAG_BL 0
#endif
#ifndef DIAG_HALF
#define DIAG_HALF 0
#endif
constexpr size_t WS_DIAG = 1015 * MiB;
constexpr size_t WS_DIAG_Q = WS_DIAG + 5 * MiB, WS_DIAG_S = WS_DIAG + 6 * MiB, WS_DIAG_R = WS_DIAG + 7 * MiB;
__device__ const int diag_h[8] = {0, 1, 2, 3, 4, 5, 6, 7};
__device__ const int diag_t[8] = {0, 63, 64, 1000, 4095, 4873, 8000, 8191};
DI void diag_pre_k(Frame& F, CArgs* ap) {
    unsigned char* ws = ap->ws; const int tid = opaque_tid();
    const v4u* src = (const v4u*)(ws + WS_KA) + (size_t)DIAG_BL * LT * 256 / 8; v4u* dst = (v4u*)(ws + WS_DIAG);
    for (int i = blockIdx.x * 512 + tid; i < LT * 256 / 8; i += ((int)gridDim.x) * 512) dst[i] = src[i];
}
DI void diag_pre_q(Frame& F, CArgs* ap) {
    unsigned char* ws = ap->ws; const int tid = opaque_tid();
    if (blockIdx.x == 0) { const bf16* QA = (const bf16*)(ws + WS_QA); bf16* dq = (bf16*)(ws + WS_DIAG_Q);
        for (int i = tid; i < 8 * 128; i += 512) { const int s = i >> 7, d = i & 127; dq[i] = QA[(size_t)(DIAG_BL * LT + LCTX + diag_t[s]) * 1024 + diag_h[s] * 128 + d]; } }
}
DI void diag_normrope(float* x  , const float* gain, int t, bool rope, int lane) {
    float a = x[lane], b = x[lane + 64]; float ss = wave_sum(a * a + b * b); const float rstd = 1.0f / sqrtf(ss / 128.0f + EPS);
    a *= rstd * gain[lane]; b *= rstd * gain[lane + 64]; x[lane] = a; x[lane + 64] = b;
    asm volatile("s_waitcnt lgkmcnt(0)" ::: "memory");
    if (rope) {
        float o[2];
        for (int q = 0; q < 2; ++q) { const int d = lane + 64 * q, axis = d >> 6, half = (d >> 5) & 1, f = d & 31; const float pos = axis ? (float)(t & 63) : (float)(t >> 6);
            const float ang = pos * powf(10000.0f, -(float)f / 32.0f); const float cs = cosf(ang), sn = sinf(ang); const float me = x[d], other = x[d ^ 32];
            o[q] = half ? (me * cs + other * sn) : (me * cs - other * sn); }
        asm volatile("s_waitcnt lgkmcnt(0)" ::: "memory");
        x[lane] = o[0]; x[lane + 64] = o[1];
        asm volatile("s_waitcnt lgkmcnt(0)" ::: "memory");
    }
}
DI void diag_post(Frame& F, CArgs* ap, LAS unsigned char* lds) {
    if (blockIdx.x != 0) return;
    unsigned char* ws = ap->ws; const int tid = opaque_tid(), lane = tid & 63, w = tid >> 6;
    float* xq = (float*)(lds) + w * 256; float* xk = xq + 128;
    const bf16* dq = (const bf16*)(ws + WS_DIAG_Q); const bf16* K = (const bf16*)(ws + WS_DIAG); const bf16* V = (const bf16*)(ws + WS_VA) + (size_t)DIAG_BL * LT * 256; float* S = (float*)(ws + WS_DIAG_S) + (size_t)w * LT;
    const int h = diag_h[w], t = diag_t[w], kvh = h >> 2;
    xq[lane] = __uint_as_float((unsigned)dq[w * 128 + lane] << 16); xq[lane + 64] = __uint_as_float((unsigned)dq[w * 128 + lane + 64] << 16);
    asm volatile("s_waitcnt lgkmcnt(0)" ::: "memory");
    diag_normrope(xq, ap->in[I_QN], t, true, lane);
    float mx = -1e30f;
    for (int j = 0; j < LT; ++j) {
        xk[lane] = __uint_as_float((unsigned)K[(size_t)j * 256 + kvh * 128 + lane] << 16); xk[lane + 64] = __uint_as_float((unsigned)K[(size_t)j * 256 + kvh * 128 + lane + 64] << 16);
        asm volatile("s_waitcnt lgkmcnt(0)" ::: "memory");
        diag_normrope(xk, ap->in[I_KN], j - LCTX, j >= LCTX, lane);
        const float sc = wave_sum(xq[lane] * xk[lane] + xq[lane + 64] * xk[lane + 64]) * 0.088388347648318440f;
        if (lane == 0) S[j] = sc; mx = fmaxf(mx, sc);
    }
    asm volatile("s_waitcnt vmcnt(0)" ::: "memory");
    float l = 0.f, o0 = 0.f, o1 = 0.f;
    for (int j = 0; j < LT; ++j) { const float p = __expf(__hip_atomic_load(S + j, __ATOMIC_RELAXED, __HIP_MEMORY_SCOPE_AGENT) - mx); l += p;
        o0 += p * __uint_as_float((unsigned)V[(size_t)j * 256 + kvh * 128 + lane] << 16); o1 += p * __uint_as_float((unsigned)V[(size_t)j * 256 + kvh * 128 + lane + 64] << 16); }
    o0 /= l; o1 /= l;
    const bf16* O = (const bf16*)(ws + WS_QA) + (size_t)(DIAG_BL * LT + LCTX + t) * 1024 + h * 128;
    const float f0 = __uint_as_float((unsigned)O[lane] << 16), f1 = __uint_as_float((unsigned)O[lane + 64] << 16);
    float err = fmaxf(fabsf(f0 - o0), fabsf(f1 - o1)), mag = fmaxf(fabsf(o0), fabsf(o1));
#define WMAX(x) do { x = fmaxf(x, lane_xor<1>(x)); x = fmaxf(x, lane_xor<2>(x)); x = fmaxf(x, lane_xor<4>(x)); x = fmaxf(x, lane_xor<8>(x)); x = fmaxf(x, lane_xor<16>(x)); \
      auto rr = __builtin_amdgcn_permlane32_swap(__float_as_uint(x), __float_as_uint(x), false, false); x = fmaxf(__uint_as_float(rr[0]), __uint_as_float(rr[1])); } while (0)
    WMAX(err); WMAX(mag);
#undef WMAX
    float* red = (float*)(lds + 16384);
    if (lane == 0) red[w] = err / mag;
    __syncthreads();
    if (tid == 0) { float m = 0.f; for (int q = 0; q < 8; ++q) m = fmaxf(m, red[q]); *(float*)(ws + WS_DIAG_R) = m; }
}
#endif
#ifndef REP_P0
#define REP_P0 1
#endif
#ifndef REP_ROUTER
#define REP_ROUTER 1
#endif
#ifndef REP_GA
#define REP_GA 1
#endif
#ifndef REP_GC
#define REP_GC 1
#endif
#ifndef REP_GM
#define REP_GM 1
#endif
#ifndef REP_GM4
#define REP_GM4 REP_GM
#endif
#ifndef REP_RET
#define REP_RET 1
#endif
#ifndef REP_PASS
#define REP_PASS 1
#endif
__global__ void __launch_bounds__(NWAVES * 64, 2) mk_fwd(Args args) {
    extern __shared__ __attribute__((aligned(16))) unsigned char lds[];
    Frame F;
    F.lds = (LAS unsigned char*)lds;
    F.MISC = (volatile LAS unsigned*)(F.lds + MISC_OFF);
    for (int u = threadIdx.x; u < (LDS_BYTES - LDSCTL_OFF) / 4; u += NWAVES * 64) ((LAS unsigned*)(F.lds + LDSCTL_OFF))[u] = 0u;
    __syncthreads();
    if ((threadIdx.x & 63) == 0) ((LAS int*)(F.lds + LDSCTL_OFF))[hw_wave_key()] = (int)(threadIdx.x >> 6);
    __syncthreads();
    (void)xcd_barrier_post((unsigned*)((gu32*)(kargs()->ws + WS_CTL) + CW_BAR), F.MISC + 8);
#define GRID_BAR() do { XcdBarrier bb_; bb_.bar = (unsigned*)((gu32*)(kargs()->ws + WS_CTL) + CW_BAR); bb_.x = (unsigned)__builtin_amdgcn_readfirstlane((int)xb_xcc_id()); \
        bb_.st = (volatile LAS unsigned*)(uintptr_t)(MISC_OFF + 32); xcd_barrier(bb_); } while (0)
#ifndef SKIP_P0
    for (int rep_ = 0; rep_ < REP_P0; ++rep_) { p0_prologue(F, kargs()); __syncthreads(); }
#endif
    GRID_BAR();
#ifndef SKIP_MODU
    for (int rep_ = 0; rep_ < REP_PASS; ++rep_) { p_modulate(F, kargs()); __syncthreads(); }
#endif
    GRID_BAR();

#pragma unroll 1
    for (int half = 0; half < 2; ++half) {
#define H1h ((const unsigned char*)(ws + WS_H1) + (size_t)half * MH * DM)
#define Yh ((bf16*)(ws + WS_Y))
#define Y8h ((unsigned char*)(ws + WS_H1) + (size_t)half * MH * DM)
#ifndef SKIP_A1
        for (int rep_ = 0; rep_ < REP_GA; ++rep_) { CArgs* ap = kargs(); unsigned char* ws = ap->ws;
            pg8::SchedA1 S{((int)gridDim.x), (int)blockIdx.x, 1};
            pg8::EpiA1 E{(bf16*)(ws + WS_QR), (bf16*)(ws + WS_KR), (bf16*)(ws + WS_VR), (bf16*)(ws + WS_KA), (bf16*)(ws + WS_VA), (const float*)(ws + WS_COSR), (const float*)(ws + WS_SINR)};
            pg8::gemm_phase<pg8::EpiA1, pg8::SchedA1, false, true>(F.lds + RING_OFF, H1h, ws + WS_WIN, DM, DM, DM, S, E, nullptr);
        }
#endif
        GRID_BAR();
#ifndef SKIP_RET
        for (int rep_ = 0; rep_ < REP_RET; ++rep_)
        for (int u = frame_vcu(); u < 256; u += ((int)gridDim.x)) { CArgs* ap = kargs(); unsigned char* ws = ap->ws;
            const int bh = u >> 4, bl = bh >> 2, h = bh & 3, dir = (u >> 3) & 1, sl = u & 7;
            const float raw = ap->in[dir ? I_DECB : I_DECF][h];
            const float lg = -log1pf(expf(raw));
            ret::ret_unit(F.lds + RING_OFF, (const bf16*)(ws + WS_QR), (const bf16*)(ws + WS_KR), (const bf16*)(ws + WS_VR), (bf16*)(ws + (dir ? WS_OB : WS_OF)), bl * LT, h, dir == 0, sl, lg);
        }
#endif
        GRID_BAR();
#ifdef DIAG_ATT
        if (half == DIAG_HALF) diag_pre_k(F, kargs());
        GRID_BAR();
#endif
#ifndef SKIP_B2
        p_knorm(F, kargs()); p_vprep(F, kargs());
#endif
#ifndef SKIP_B1
        for (int rep_ = 0; rep_ < REP_GA; ++rep_) { CArgs* ap = kargs(); unsigned char* ws = ap->ws;
            pg8::SchedB1 S{((int)gridDim.x), (int)blockIdx.x, 1};
            pg8::EpiB1 E{(bf16*)(ws + WS_GR), (bf16*)(ws + WS_QA), (bf16*)(ws + WS_KA), (bf16*)(ws + WS_VA), (bf16*)(ws + WS_GTR), (bf16*)(ws + WS_GTA)};
            pg8::gemm_phase<pg8::EpiB1, pg8::SchedB1, false, true>(F.lds + RING_OFF, H1h, ws + WS_WIN + (size_t)4096 * DM, DM, DM, DM, S, E, nullptr);
        }
#endif
        GRID_BAR();
#ifdef DIAG_ATT
        if (half == DIAG_HALF) diag_pre_q(F, kargs());
        GRID_BAR();
#endif
        const int ar_slot_ = frame_vcu() % (1024 / (int)gridDim.x + 1);
#ifndef SKIP_ATT
        for (int u = frame_vcu(); u < 1024; u += ((int)gridDim.x)) { CArgs* ap = kargs(); unsigned char* ws = ap->ws;
#ifndef SKIP_B2
            if ((u - frame_vcu()) / (int)gridDim.x == ar_slot_) p_ar(F, kargs());
#endif
            const int grp = u >> 7, w = u & 127, bl = grp >> 1, kvh = grp & 1, h = kvh * 4 + (w >> 5), qb = w & 31;
            bf16* Qb = (bf16*)(ws + WS_QA) + (size_t)(bl * LT + LCTX + qb * 256) * 1024 + h * 128;
            const unsigned char* Kh = ws + WS_KA8 + ((size_t)kvh * MH + (size_t)bl * LT) * 128;
            const unsigned char* Vh = ws + WS_VA8 + ((size_t)kvh * (MH / 64) + (size_t)bl * (LT / 64)) * 8192;
            att::attn_dense_body(Qb, Kh, Vh, Qb, ws + WS_O8 + (size_t)(bl * LT + LCTX + qb * 256) * 1024 + h * 128, LT, F.lds + RING_OFF, qb * 256, ap->in[I_QN], (const float*)(ws + WS_COSA), (const float*)(ws + WS_SINA));
        }
#endif
#ifndef SKIP_B2
        if (ar_slot_ >= (1024 - frame_vcu() + (int)gridDim.x - 1) / (int)gridDim.x) p_ar(F, kargs());
#endif
        GRID_BAR();
#ifdef DIAG_ATT
        if (half == DIAG_HALF) diag_post(F, kargs(), F.lds);
        GRID_BAR();
#endif
#ifndef SKIP_C12
        for (int rep_ = 0; rep_ < REP_GC; ++rep_) { CArgs* ap = kargs(); unsigned char* ws = ap->ws;
            pg8::SchedLat S1{((int)gridDim.x), (int)blockIdx.x, 4096, 2048};
            pg8::EpiGate<false> E1{Yh, ws + WS_GTR, nullptr};
            pg8::gemm_phase<pg8::EpiGate<false>, pg8::SchedLat, false, true>(F.lds + RING_OFF, ws + WS_GR, ws + WS_WRO, 4096, 2048, 2048, S1, E1, nullptr);
            ap = kargs(); ws = ap->ws;
            pg8::SchedLat S2{((int)gridDim.x), (int)blockIdx.x, 1024, 1024};
            pg8::EpiGate<true> E2{Yh, ws + WS_GTA, Y8h};
            pg8::gemm_phase<pg8::EpiGate<true>, pg8::SchedLat, false, true>(F.lds + RING_OFF, ws + WS_O8, ws + WS_WAO, 1024, 1024, 1024, S2, E2, nullptr);
        }
#endif
        GRID_BAR();
#ifndef SKIP_C3
        for (int rep_ = 0; rep_ < REP_GC; ++rep_) { CArgs* ap = kargs(); unsigned char* ws = ap->ws;
            pg8::SchedLat S{((int)gridDim.x), (int)blockIdx.x, 1024, 1024};
            pg8::EpiOut E{ap->in[I_X], ap->out, (const float*)(ws + WS_MOD), half};
            pg8::gemm_phase<pg8::EpiOut, pg8::SchedLat, false, true>(F.lds + RING_OFF, Y8h, ws + WS_WOUT, 1024, 1024, 1024, S, E, nullptr);
        }
#endif
        if (half == 1) GRID_BAR();
#undef H1h
#undef Yh
#undef Y8h
    }

#ifndef SKIP_ROUTER
    for (int rep_ = 0; rep_ < REP_ROUTER; ++rep_) { p_router(F, kargs()); __syncthreads(); }
#endif
    GRID_BAR();
#ifndef SKIP_SORT
    for (int rep_ = 0; rep_ < REP_PASS; ++rep_) { p_sort(F, kargs()); __syncthreads(); }
#endif
    GRID_BAR();
#pragma unroll 1
    for (int th = 0; th < 2; ++th) {
#ifndef SKIP_M3
        for (int rep_ = 0; rep_ < REP_GM; ++rep_) { CArgs* ap = kargs(); unsigned char* ws = ap->ws;
            pg8::SchedMoe S{((int)gridDim.x), (int)blockIdx.x, 8, (const int*)(ws + WS_TILEB + (size_t)th * TH_TAB), (size_t)2048 * 1024, 1024, 1024, true};
            pg8::EpiSwiglu E{(unsigned char*)(ws + WS_ACT), ap->in[I_B1], (const int*)(ws + WS_TILEB + (size_t)th * TH_TAB)};
            pg8::gemm_phase<pg8::EpiSwiglu, pg8::SchedMoe, true, true>(F.lds + RING_OFF, ws + WS_H2, ws + WS_W1, 1024, 1024, 1024, S, E, (const int*)(ws + WS_ROWTOK + (size_t)th * TH_TAB));
        }
#endif
        GRID_BAR();
#ifndef SKIP_M4
        for (int rep_ = 0; rep_ < REP_GM4; ++rep_) { CArgs* ap = kargs(); unsigned char* ws = ap->ws;
            pg8::SchedMoe S{((int)gridDim.x), (int)blockIdx.x, 4, (const int*)(ws + WS_TILEB + (size_t)th * TH_TAB), (size_t)1024 * 1024, 1024, 1024, false};
            pg8::EpiDown E{(bf16*)(ws + WS_Y2), ap->in[I_B2], (const int*)(ws + WS_TILEB + (size_t)th * TH_TAB), (const float*)(ws + WS_ROWW + (size_t)th * TH_TAB)};
            pg8::gemm_phase<pg8::EpiDown, pg8::SchedMoe, false, true>(F.lds + RING_OFF, ws + WS_ACT, ws + WS_W2, 1024, 1024, 1024, S, E, nullptr);
        }
#endif
        GRID_BAR();
#ifndef SKIP_COMB
        p_combine(F, kargs(), th);
#endif
#ifdef DIAG_ATT
        GRID_BAR();
#endif
        __syncthreads();
    }
#ifdef DIAG_FILL
    { CArgs* ap = kargs(); const int tid = opaque_tid(); f32x4 z = {0.f, 0.f, 0.f, 0.f}; for (size_t i = (size_t)blockIdx.x * 512 + tid; i < (size_t)TTOK * DM / 4; i += (size_t)gridDim.x * 512) ((f32x4*)ap->out)[i] = z; }
    GRID_BAR();
#endif
#ifdef DIAG_ATT
    if (blockIdx.x == 0 && opaque_tid() == 0) { CArgs* ap = kargs(); const float v = __hip_atomic_load((const float*)(ap->ws + WS_DIAG_R), __ATOMIC_RELAXED, __HIP_MEMORY_SCOPE_AGENT); ap->out[0] += 1.0e6f * v; }
#endif
#undef GRID_BAR
}

extern "C" void kernel_launch(void* const* d_in, const int* in_sizes, int n_in, void* d_out, int out_size, void* d_ws, size_t ws_size, hipStream_t stream) {
    static int grid = 0;
    if (grid == 0) {
        if (n_in != 22 || in_sizes[0] != TTOK * DM || out_size != TTOK * DM || ws_size < WS_END) {
            fprintf(stderr, "kernel_launch: shape mismatch n_in %d in0 %d out %d ws %zu (need %zu)\n", n_in, n_in > 0 ? in_sizes[0] : -1, out_size, ws_size, (size_t)WS_END); grid = -1; return; }
        int dev = 0, cus = 0, per_cu = 0;
        if (hipGetDevice(&dev) != hipSuccess || hipDeviceGetAttribute(&cus, hipDeviceAttributeMultiprocessorCount, dev) != hipSuccess) { grid = -1; return; }
        if (hipFuncSetAttribute((const void*)mk_fwd, hipFuncAttributeMaxDynamicSharedMemorySize, LDS_BYTES) != hipSuccess) { fprintf(stderr, "kernel_launch: hipFuncSetAttribute failed\n"); grid = -1; return; }
        if (hipOccupancyMaxActiveBlocksPerMultiprocessor(&per_cu, (const void*)mk_fwd, NWAVES * 64, LDS_BYTES) != hipSuccess || per_cu < 1)
            fprintf(stderr, "kernel_launch: occupancy query reports %d\n", per_cu);
        (void)hipGetLastError();
        grid = cus;
    }
    if (grid < 0) return;
    if (hipMemsetAsync((char*)d_ws + WS_CTL, 0, CTL_ZERO_BYTES, stream) != hipSuccess) return;
    Args a{};
    for (int i = 0; i < 22; ++i) a.in[i] = (const float*)d_in[i];
    a.out = (float*)d_out; a.ws = (unsigned char*)d_ws;
    hipLaunchKernelGGL(mk_fwd, dim3(grid), dim3(NWAVES * 64), LDS_BYTES, stream, a);
    const hipError_t le = hipPeekAtLastError();
    if (le != hipSuccess) fprintf(stderr, "kernel_launch: launch failed: %s\n", hipGetErrorName(le));
}
```
